# Optimizing an MI355X kernel written in HIP

```python
import math
import jax, jax.numpy as jnp
from jax import lax
import numpy as np

D_MODEL = 1024
BATCH = 8
SEQ = 4096
DEPTH = 4

HEAD_DIM = 64
N_HEADS = D_MODEL // HEAD_DIM
H_DSA = N_HEADS // 2
H_FOX = N_HEADS - H_DSA
D_LATENT = D_MODEL // 8
H_IDX = 8
D_IDX = 64
TOPK_MAX = 256
Q_BLOCK = 128
D_FF = ((8 * D_MODEL // 3 + 127) // 128) * 128
N_BUCKETS = 32
MAX_DISTANCE = 128
EPS = 1e-6
NEG = -1e30

kernel_name = 'hybrid_dsa_fox_macaron'


def rms_norm(x, g):
    xf = x.astype(jnp.float32)
    y = xf * lax.rsqrt(jnp.mean(xf * xf, axis=-1, keepdims=True) + EPS)
    return (y * g.astype(jnp.float32)).astype(x.dtype)


def swiglu(x, w_gate, w_up, w_down):
    return (jax.nn.silu(x @ w_gate) * (x @ w_up)) @ w_down


def t5_bucket(dist):
    n = jnp.maximum(dist, 0)
    max_exact = N_BUCKETS // 2
    nf = jnp.maximum(n, 1).astype(jnp.float32)
    large = max_exact + (jnp.log(nf / max_exact) / math.log(MAX_DISTANCE / max_exact)
                         * (N_BUCKETS - max_exact)).astype(jnp.int32)
    large = jnp.minimum(large, N_BUCKETS - 1)
    return jnp.where(n < max_exact, n, large)


def to_blocks(a):
    b, s = a.shape[:2]
    return jnp.moveaxis(a.reshape((b, s // Q_BLOCK, Q_BLOCK) + a.shape[2:]), 1, 0)


def from_blocks(a):
    nb, b, qb = a.shape[:3]
    return jnp.moveaxis(a, 0, 1).reshape((b, nb * qb) + a.shape[3:])


def dsa_attention(q, c_kv, q_idx, k_idx, w_idx, w_uk, w_uv, rel_bias):
    b, s = q.shape[:2]
    k_sel = min(TOPK_MAX, s // 4)
    q_lat = jnp.einsum('bshd,chd->bshc', q, w_uk)
    key_pos = jnp.arange(s)

    def block(args):
        blk, ql, qi, wi = args
        t = blk * Q_BLOCK + jnp.arange(Q_BLOCK)
        rel = jnp.einsum('bqhd,bsd->bqhs', qi, k_idx).astype(jnp.float32) * (D_IDX ** -0.5)
        score = jnp.einsum('bqh,bqhs->bqs', wi.astype(jnp.float32) * (H_IDX ** -0.5), jax.nn.relu(rel))
        score = jnp.where(key_pos[None, None, :] <= t[None, :, None], score, NEG)
        _, idx = lax.top_k(score, k_sel)
        c_sel = jax.vmap(lambda cb, ib: cb[ib])(c_kv, idx)
        dist = t[None, :, None] - idx
        bias = jnp.moveaxis(rel_bias[t5_bucket(dist)], -1, 2)
        logits = (jnp.einsum('bqhc,bqkc->bqhk', ql, c_sel).astype(jnp.float32) * (HEAD_DIM ** -0.5)
                  + bias.astype(jnp.float32))
        logits = jnp.where((dist >= 0)[:, :, None, :], logits, NEG)
        p = jax.nn.softmax(logits, axis=-1).astype(c_kv.dtype)
        return jnp.einsum('bqhk,bqkc->bqhc', p, c_sel)

    nb = s // Q_BLOCK
    o_lat = from_blocks(lax.map(block, (jnp.arange(nb), to_blocks(q_lat), to_blocks(q_idx), to_blocks(w_idx))))
    return jnp.einsum('bshc,chd->bshd', o_lat, w_uv)


def fox_attention(q, k, v, log_f):
    b, s = q.shape[:2]
    cum = jnp.cumsum(log_f, axis=1)
    cum_k = jnp.moveaxis(cum, 1, 2)
    key_pos = jnp.arange(s)

    def block(args):
        blk, qb, cq = args
        t = blk * Q_BLOCK + jnp.arange(Q_BLOCK)
        logits = (jnp.einsum('bqhd,bshd->bhqs', qb, k).astype(jnp.float32) * (HEAD_DIM ** -0.5)
                  + jnp.moveaxis(cq, 1, 2)[..., None] - cum_k[:, :, None, :])
        logits = jnp.where(key_pos[None, None, None, :] <= t[None, None, :, None], logits, NEG)
        p = jax.nn.softmax(logits, axis=-1).astype(v.dtype)
        return jnp.einsum('bhqs,bshd->bqhd', p, v)

    nb = s // Q_BLOCK
    return from_blocks(lax.map(block, (jnp.arange(nb), to_blocks(q), to_blocks(cum))))


def token_mixing(h, w_in, b_forget, g_ckv, w_uk, w_uv, w_out, rel_bias):
    b, s, _ = h.shape
    sizes = [H_DSA * HEAD_DIM, D_LATENT, H_IDX * D_IDX, D_IDX, H_IDX, 3 * H_FOX * HEAD_DIM, H_FOX]
    points = []
    acc = 0
    for sz in sizes[:-1]:
        acc += sz
        points.append(acc)
    proj = h @ w_in
    q_a, c_raw, q_i, k_i, w_i, qkv_f, f_logit = jnp.split(proj, points, axis=-1)
    q_a = q_a.reshape(b, s, H_DSA, HEAD_DIM)
    c_kv = rms_norm(c_raw, g_ckv)
    q_i = q_i.reshape(b, s, H_IDX, D_IDX)
    qkv_f = qkv_f.reshape(b, s, 3, H_FOX, HEAD_DIM)
    log_f = jax.nn.log_sigmoid(f_logit.astype(jnp.float32) + b_forget.astype(jnp.float32))
    o_a = dsa_attention(q_a, c_kv, q_i, k_i, w_i, w_uk, w_uv, rel_bias)
    o_f = fox_attention(qkv_f[:, :, 0], qkv_f[:, :, 1], qkv_f[:, :, 2], log_f)
    o = jnp.concatenate([o_a.reshape(b, s, H_DSA * HEAD_DIM), o_f.reshape(b, s, H_FOX * HEAD_DIM)], axis=-1)
    return o @ w_out


def setup_inputs(seed: int = 0) -> dict:
    key = jax.random.key(seed)
    ks = jax.random.split(key, 20)
    in_width = H_DSA * HEAD_DIM + D_LATENT + H_IDX * D_IDX + D_IDX + H_IDX + 3 * H_FOX * HEAD_DIM + H_FOX
    f32 = jnp.float32

    def nrm(k, shape, fan_in):
        return jax.random.normal(k, shape, f32) * (fan_in ** -0.5)

    def gain(k, shape):
        return 1.0 + 0.05 * jax.random.normal(k, shape, f32)

    return {
        'x': jax.random.normal(ks[0], (BATCH, SEQ, D_MODEL), f32),
        'ffn1_norm': gain(ks[1], (DEPTH, D_MODEL)),
        'ffn1_gate': nrm(ks[2], (DEPTH, D_MODEL, D_FF), D_MODEL),
        'ffn1_up': nrm(ks[3], (DEPTH, D_MODEL, D_FF), D_MODEL),
        'ffn1_down': nrm(ks[4], (DEPTH, D_FF, D_MODEL), D_FF),
        'mix_norm': gain(ks[5], (DEPTH, D_MODEL)),
        'w_in': nrm(ks[6], (DEPTH, D_MODEL, in_width), D_MODEL),
        'b_forget': 2.0 + 3.0 * jax.random.uniform(ks[7], (DEPTH, H_FOX), f32),
        'ckv_norm': gain(ks[8], (DEPTH, D_LATENT)),
        'w_uk': nrm(ks[9], (DEPTH, D_LATENT, H_DSA, HEAD_DIM), D_LATENT),
        'w_uv': nrm(ks[10], (DEPTH, D_LATENT, H_DSA, HEAD_DIM), D_LATENT),
        'w_out': nrm(ks[11], (DEPTH, D_MODEL, D_MODEL), D_MODEL),
        'ffn2_norm': gain(ks[12], (DEPTH, D_MODEL)),
        'ffn2_gate': nrm(ks[13], (DEPTH, D_MODEL, D_FF), D_MODEL),
        'ffn2_up': nrm(ks[14], (DEPTH, D_MODEL, D_FF), D_MODEL),
        'ffn2_down': nrm(ks[15], (DEPTH, D_FF, D_MODEL), D_FF),
        'rel_bias': 0.5 * jax.random.normal(ks[16], (N_BUCKETS, H_DSA), f32),
        'final_norm': gain(ks[17], (D_MODEL,)),
    }


def reference(x, ffn1_norm, ffn1_gate, ffn1_up, ffn1_down, mix_norm, w_in, b_forget, ckv_norm,
              w_uk, w_uv, w_out, ffn2_norm, ffn2_gate, ffn2_up, ffn2_down, rel_bias, final_norm):
    h = x
    for l in range(DEPTH):
        h = h + 0.5 * swiglu(rms_norm(h, ffn1_norm[l]), ffn1_gate[l], ffn1_up[l], ffn1_down[l])
        h = h + token_mixing(rms_norm(h, mix_norm[l]), w_in[l], b_forget[l], ckv_norm[l],
                             w_uk[l], w_uv[l], w_out[l], rel_bias)
        h = h + 0.5 * swiglu(rms_norm(h, ffn2_norm[l]), ffn2_gate[l], ffn2_up[l], ffn2_down[l])
    return rms_norm(h, final_norm)
```

```cpp
#include <hip/hip_runtime.h>
#include <hip/hip_bf16.h>
#include <cstdio>
#include <cstdint>
#include <cmath>
namespace pg8 {
#define PG8_LAS __attribute__((address_space(3)))
typedef unsigned short bf16_t;
typedef short bf16x8 __attribute__((ext_vector_type(8)));
typedef float f32x4 __attribute__((ext_vector_type(4)));
typedef unsigned u32x4 __attribute__((ext_vector_type(4)));
constexpr int BM = 256, BK = 64, HALF = 128, HTB = HALF * BK * 2  , STAGE_BYTES = 8 * HTB, NXCD = 8, WGM = 8;

__host__ __device__ __forceinline__ int lds_byte(int r, int c) { const int st = (r >> 4) * 2 + (c >> 5), rr = r & 15, cc = c & 31, ob = rr * 64 + cc * 2; return st * 1024 + (ob ^ (((ob >> 9) & 1) << 5)); }
__host__ __device__ __forceinline__ void stage_rc(int b, int& R, int& C) { const int st = b / 1024, sb = b % 1024, swz = sb ^ (((sb >> 9) & 1) << 5); R = (st >> 1) * 16 + swz / 64; C = (st & 1) * 32 + (swz % 64) / 2; }
__host__ __device__ __forceinline__ int perm32(int rho) { const int n = rho >> 4, i = rho & 15; return 8 * (i >> 2) + 4 * n + (i & 3); }

struct Unit { int pm, pn; };
struct Gemm { const bf16_t* A; const bf16_t* Bt; int M, N, K; };

struct StaticOrder {
    int nM, nN, nwg, G, c;
    __host__ __device__ void init(int M, int N, int G_, int c_) { nM = M / BM; nN = N / BM; nwg = nM * nN; G = G_; c = c_; }
    __host__ __device__ bool next(int i, Unit& u) const {
        const long L = (long)i * G + c; if (L >= nwg) return false;
        int wgid = (int)L; { const int q = nwg / NXCD, r = nwg % NXCD, xcd = wgid % NXCD, off = wgid / NXCD; wgid = (xcd < r ? xcd * (q + 1) : r * (q + 1) + (xcd - r) * q) + off; }
        const int nig = WGM * nN, gid = wgid / nig, fm = gid * WGM, gsz = (nM - fm) < WGM ? (nM - fm) : WGM;
        u.pm = fm + ((wgid % nig) % gsz); u.pn = (wgid % nig) / gsz; return true;
    }
    __device__ __forceinline__ void a_ready(const Unit&) const {}
    __device__ __forceinline__ void done(const Unit&) const {}
};

__device__ __forceinline__ unsigned cvt_pk_bf16(float lo, float hi) { unsigned r; asm volatile("v_cvt_pk_bf16_f32 %0, %1, %2" : "=v"(r) : "v"(lo), "v"(hi)); return r; }
typedef float f32x2 __attribute__((ext_vector_type(2)));
constexpr float RMS_EPS = 1e-6f;
constexpr float K_LOG2E = 1.4426950408889634f;
constexpr float K_C2 = 0.125f * 1.4426950408889634f;
__device__ __forceinline__ float row_rstd(const float* ssq, int row) {
    const f32x4* p = (const f32x4*)(ssq + (size_t)row * 16);
    const f32x4 a = p[0], b = p[1], c = p[2], d = p[3];
    const float s = (((a[0] + a[1]) + (a[2] + a[3])) + ((b[0] + b[1]) + (b[2] + b[3]))) + (((c[0] + c[1]) + (c[2] + c[3])) + ((d[0] + d[1]) + (d[2] + d[3])));
    return 1.0f / sqrtf(s * (1.0f / 1024.0f) + RMS_EPS);
}
struct EpiSwiGLU {
    static constexpr bool PERM = true, AFTER_DRAIN = false;
    bf16_t* H; int ldh; const float* ssq;
    __device__ __forceinline__ void operator()(const f32x4 (&acc)[2][2][4][2], const Unit& u, int wr, int wc, int fr, int fq) const {
        const int row0 = u.pm * BM + wr * 64 + fr, col0 = u.pn * HALF + wc * 32 + 8 * fq;
#pragma unroll
        for (int ai = 0; ai < 2; ++ai)
#pragma unroll
            for (int m = 0; m < 4; ++m) {
                const int row = row0 + ai * HALF + m * 16; const float rs = row_rstd(ssq, row);
                float h[8];
#pragma unroll
                for (int n = 0; n < 2; ++n)
#pragma unroll
                    for (int e = 0; e < 4; ++e) { const float g = acc[ai][0][m][n][e] * rs, uu = acc[ai][1][m][n][e] * rs;
                        const float sg = g * __builtin_amdgcn_rcpf(1.0f + __builtin_amdgcn_exp2f(-K_LOG2E * g)); h[4 * n + e] = sg * uu; }
                u32x4 w; w.x = cvt_pk_bf16(h[0], h[1]); w.y = cvt_pk_bf16(h[2], h[3]); w.z = cvt_pk_bf16(h[4], h[5]); w.w = cvt_pk_bf16(h[6], h[7]);
                *(u32x4*)(H + (size_t)row * ldh + col0) = w;
                asm volatile("" ::: "memory");
            }
    }
};
struct EpiRes {
    static constexpr bool PERM = false, AFTER_DRAIN = false;
    const float* base; float* out; bf16_t* hb; float* ssq; float scale;
    __device__ __forceinline__ void operator()(const f32x4 (&acc)[2][2][4][2], const Unit& u, int wr, int wc, int fr, int fq) const {
        typedef unsigned u32x2v __attribute__((ext_vector_type(2)));
        const int col0 = u.pn * BM + wc * 32 + 4 * fq;
#pragma unroll
        for (int ai = 0; ai < 2; ++ai)
#pragma unroll
            for (int m = 0; m < 4; ++m) {
                const int row = u.pm * BM + ai * HALF + wr * 64 + m * 16 + fr; const size_t off = (size_t)row * 1024 + col0;
                float ss = 0.f;
#pragma unroll
                for (int bj = 0; bj < 2; ++bj)
#pragma unroll
                    for (int n = 0; n < 2; ++n) { const f32x4 bs = *(const f32x4*)(base + off + bj * HALF + n * 16); const f32x4 o = bs + acc[ai][bj][m][n] * scale;
                        *(f32x4*)(out + off + bj * HALF + n * 16) = o; u32x2v w; w.x = cvt_pk_bf16(o[0], o[1]); w.y = cvt_pk_bf16(o[2], o[3]); *(u32x2v*)(hb + off + bj * HALF + n * 16) = w;
                        ss += (o[0] * o[0] + o[1] * o[1]) + (o[2] * o[2] + o[3] * o[3]); }
                ss += __shfl_xor(ss, 16); ss += __shfl_xor(ss, 32);
                if (fq == 0) ssq[(size_t)row * 16 + u.pn * 4 + wc] = ss;
                asm volatile("" ::: "memory");
            }
    }
};
struct EpiProj {
    static constexpr bool PERM = true, AFTER_DRAIN = false;
    bf16_t *ATT, *QI, *FK, *FV, *KI; float *CR, *WI, *FL; const float* ssq;
    __device__ __forceinline__ void operator()(const f32x4 (&acc)[2][2][4][2], const Unit& u, int wr, int wc, int fr, int fq) const {
        const int row0 = u.pm * BM + wr * 64 + fr, pn = u.pn, cl = wc * 32 + 8 * fq;
        if (pn < 12) {
            bf16_t* base; int ld, colt; float sc;
            if (pn < 4) { base = ATT; ld = 1536; colt = pn * 256; sc = K_C2; }
            else if (pn < 6) { base = QI; ld = 512; colt = (pn - 4) * 256; sc = 0.125f; }
            else if (pn < 8) { base = ATT; ld = 1536; colt = 1024 + (pn - 6) * 256; sc = K_C2; }
            else if (pn < 10) { base = FK; ld = 512; colt = (pn - 8) * 256; sc = 1.0f; }
            else { base = FV; ld = 512; colt = (pn - 10) * 256; sc = 1.0f; }
#pragma unroll
            for (int ai = 0; ai < 2; ++ai)
#pragma unroll
                for (int m = 0; m < 4; ++m) {
                    const int row = row0 + ai * HALF + m * 16; const float rs = row_rstd(ssq, row) * sc; bf16_t* rowp = base + (size_t)row * ld + colt + cl;
#pragma unroll
                    for (int bj = 0; bj < 2; ++bj) { const f32x4 v0 = acc[ai][bj][m][0] * rs, v1 = acc[ai][bj][m][1] * rs;
                        u32x4 w; w.x = cvt_pk_bf16(v0[0], v0[1]); w.y = cvt_pk_bf16(v0[2], v0[3]); w.z = cvt_pk_bf16(v1[0], v1[1]); w.w = cvt_pk_bf16(v1[2], v1[3]);
                        *(u32x4*)(rowp + bj * HALF) = w; }
                    asm volatile("" ::: "memory");
                }
        } else {
#pragma unroll
            for (int ai = 0; ai < 2; ++ai)
#pragma unroll
                for (int m = 0; m < 4; ++m) {
                    const int row = row0 + ai * HALF + m * 16; const float rs = row_rstd(ssq, row);
                    *(f32x4*)(CR + (size_t)row * 128 + cl) = acc[ai][0][m][0] * rs; *(f32x4*)(CR + (size_t)row * 128 + cl + 4) = acc[ai][0][m][1] * rs;
                    const f32x4 v0 = acc[ai][1][m][0] * rs, v1 = acc[ai][1][m][1] * rs;
                    if (wc < 2) { u32x4 w; w.x = cvt_pk_bf16(v0[0], v0[1]); w.y = cvt_pk_bf16(v0[2], v0[3]); w.z = cvt_pk_bf16(v1[0], v1[1]); w.w = cvt_pk_bf16(v1[2], v1[3]);
                        *(u32x4*)(KI + (size_t)row * 64 + cl) = w; }
                    else if (wc == 2) {
                        if (fq == 0) { const float s8 = 0.35355339059327373f; *(f32x4*)(WI + (size_t)row * 8) = v0 * s8; *(f32x4*)(WI + (size_t)row * 8 + 4) = v1 * s8; }
                        else if (fq == 1) { *(f32x4*)(FL + (size_t)row * 8) = v0; *(f32x4*)(FL + (size_t)row * 8 + 4) = v1; }
                    }
                    asm volatile("" ::: "memory");
                }
        }
    }
};

template <class Epi, class Sched, bool ALIGN_EPI = false, bool SP2 = false>
__device__ __forceinline__ void gemm_phase(PG8_LAS unsigned char* lds, const Gemm g, const Sched& S, const Epi& E) {
    int tid_ = threadIdx.x; asm volatile("" : "+v"(tid_));
    const int tid = tid_, wid = __builtin_amdgcn_readfirstlane(tid >> 6), lane = tid & 63, wr = wid >> 2, wc = wid & 3, fr = lane & 15, fq = lane >> 4;
    const int K = g.K, nt = K / BK;
    unsigned voffA[2], voffB[2];
#pragma unroll
    for (int i = 0; i < 2; ++i) { int R, C; stage_rc(tid * 16 + i * 8192, R, C); const int Rb = Epi::PERM ? ((R & ~31) + perm32(R & 31)) : R;
        voffA[i] = (unsigned)(R * K + C) * 2u; voffB[i] = (unsigned)(Rb * K + C) * 2u; }
    const size_t kstep = (size_t)(BK * 2);
    const size_t hstep = (size_t)HALF * K * 2;
    const size_t tstep = 2 * hstep;
    const unsigned ldsw = (unsigned)wid * 1024u;
    const int aoff = lds_byte(wr * 64 + fr, fq * 8), boff = lds_byte(wc * 32 + fr, fq * 8);
#define PG8_SA(b, h) (((b) * 2 + (h)) * HTB)
#define PG8_SB(b, h) ((4 + (b) * 2 + (h)) * HTB)
#define PG8_STAGE(bufoff, gbase, voff) do { _Pragma("unroll") for (int _i = 0; _i < 2; ++_i) \
        __builtin_amdgcn_global_load_lds((const unsigned*)((const char*)(gbase) + (voff)[_i]), (PG8_LAS unsigned*)(lds + (bufoff) + ldsw + _i * 8192), 16, 0, 0); } while (0)
#define PG8_LDA(dst, b, h) do { _Pragma("unroll") for (int m = 0; m < 4; ++m) _Pragma("unroll") for (int k = 0; k < 2; ++k) dst[m][k] = *(const PG8_LAS bf16x8*)(lds + PG8_SA(b, h) + aoff + m * 2048 + k * 1024); } while (0)
#define PG8_LDB(dst, b, h) do { _Pragma("unroll") for (int n = 0; n < 2; ++n) _Pragma("unroll") for (int k = 0; k < 2; ++k) dst[n][k] = *(const PG8_LAS bf16x8*)(lds + PG8_SB(b, h) + boff + n * 2048 + k * 1024); } while (0)
#define PG8_MMA(ai, bj, At, Bt) do { __builtin_amdgcn_s_setprio(1); _Pragma("unroll") for (int m = 0; m < 4; ++m) _Pragma("unroll") for (int n = 0; n < 2; ++n) _Pragma("unroll") for (int k = 0; k < 2; ++k) \
        acc[ai][bj][m][n] = __builtin_amdgcn_mfma_f32_16x16x32_bf16(Bt[n][k], At[m][k], acc[ai][bj][m][n], 0, 0, 0); __builtin_amdgcn_s_setprio(0); } while (0)
#define PG8_WAIT_V(n) asm volatile("s_waitcnt vmcnt(" #n ")" ::: "memory")
#define PG8_WAIT_L(n) asm volatile("s_waitcnt lgkmcnt(" #n ")" ::: "memory")
#define PG8_BAR __builtin_amdgcn_s_barrier()
#define PG8_SCHED __builtin_amdgcn_sched_barrier(0)
    Unit cur, nxt; int ui = 0;
    if (!S.next(0, cur)) return;
    f32x4 acc[2][2][4][2];
#pragma unroll
    for (int a = 0; a < 2; ++a)
#pragma unroll
        for (int b = 0; b < 2; ++b)
#pragma unroll
            for (int m = 0; m < 4; ++m)
#pragma unroll
                for (int n = 0; n < 2; ++n) acc[a][b][m][n] = (f32x4){0.f, 0.f, 0.f, 0.f};
    bf16x8 At[4][2], B0[2][2], B1[2][2];
    const char* cA = (const char*)g.A + (size_t)cur.pm * tstep; const char* cB = (const char*)g.Bt + (size_t)cur.pn * tstep;
    S.a_ready(cur);
    if constexpr (SP2) {
        PG8_STAGE(PG8_SB(0, 0), cB, voffB); PG8_STAGE(PG8_SB(0, 1), cB + hstep, voffB); PG8_STAGE(PG8_SA(0, 0), cA, voffA); PG8_STAGE(PG8_SA(0, 1), cA + hstep, voffA);
        if (wr == 1) PG8_BAR;
        PG8_WAIT_V(2); PG8_BAR;
        PG8_STAGE(PG8_SB(1, 0), cB + kstep, voffB); PG8_STAGE(PG8_SA(1, 0), cA + kstep, voffA); PG8_STAGE(PG8_SB(1, 1), cB + hstep + kstep, voffB);
        PG8_WAIT_V(6); PG8_BAR;
    } else {
        PG8_STAGE(PG8_SB(0, 0), cB, voffB); PG8_STAGE(PG8_SA(0, 0), cA, voffA); PG8_STAGE(PG8_SB(0, 1), cB + hstep, voffB); PG8_STAGE(PG8_SA(0, 1), cA + hstep, voffA);
        if (wr == 1) PG8_BAR;
        PG8_WAIT_V(4); PG8_BAR;
        PG8_STAGE(PG8_SB(1, 0), cB + kstep, voffB); PG8_STAGE(PG8_SA(1, 0), cA + kstep, voffA); PG8_STAGE(PG8_SB(1, 1), cB + hstep + kstep, voffB);
        PG8_WAIT_V(6); PG8_BAR;
    }
    for (;;) {
        const bool has_next = S.next(ui + 1, nxt);
        const char* nA = has_next ? (const char*)g.A + (size_t)nxt.pm * tstep : cA; const char* nB = has_next ? (const char*)g.Bt + (size_t)nxt.pn * tstep : cB;
        for (int t = 0; t < nt; t += 2) {
            const bool last = (t == nt - 2);
            const char* a1 = cA + (size_t)(t + 1) * kstep;
            const char* a2 = last ? nA : cA + (size_t)(t + 2) * kstep; const char* b2 = last ? nB : cB + (size_t)(t + 2) * kstep;
            const char* a3 = a2 + kstep; const char* b3 = b2 + kstep;
            if (last && has_next) S.a_ready(nxt);
            if constexpr (SP2) {
            PG8_LDB(B0, 0, 0); PG8_LDB(B1, 0, 1); PG8_SCHED; PG8_LDA(At, 0, 0); PG8_STAGE(PG8_SA(1, 1), a1 + hstep, voffA);
            PG8_WAIT_V(8); PG8_WAIT_L(0); PG8_BAR; PG8_MMA(0, 0, At, B0); PG8_MMA(0, 1, At, B1); PG8_BAR; PG8_SCHED;
            PG8_LDA(At, 0, 1); PG8_STAGE(PG8_SB(0, 0), b2, voffB); PG8_STAGE(PG8_SB(0, 1), b2 + hstep, voffB); PG8_STAGE(PG8_SA(0, 0), a2, voffA);
            PG8_WAIT_V(8); PG8_WAIT_L(0); PG8_BAR; PG8_MMA(1, 0, At, B0); PG8_MMA(1, 1, At, B1); PG8_BAR; PG8_SCHED;
            PG8_LDB(B0, 1, 0); PG8_LDB(B1, 1, 1); PG8_SCHED; PG8_LDA(At, 1, 0); PG8_STAGE(PG8_SA(0, 1), a2 + hstep, voffA);
            PG8_WAIT_V(8); PG8_WAIT_L(0); PG8_BAR; PG8_MMA(0, 0, At, B0); PG8_MMA(0, 1, At, B1); PG8_BAR; PG8_SCHED;
            PG8_LDA(At, 1, 1); PG8_STAGE(PG8_SB(1, 0), b3, voffB); PG8_STAGE(PG8_SB(1, 1), b3 + hstep, voffB); PG8_STAGE(PG8_SA(1, 0), a3, voffA);
            PG8_WAIT_V(8); PG8_WAIT_L(0); PG8_BAR; PG8_MMA(1, 0, At, B0); PG8_MMA(1, 1, At, B1); PG8_BAR; PG8_SCHED;
            } else {
            PG8_LDB(B0, 0, 0); PG8_SCHED; PG8_LDA(At, 0, 0); PG8_STAGE(PG8_SA(1, 1), a1 + hstep, voffA);
            PG8_WAIT_L(8); PG8_BAR; PG8_WAIT_L(0); PG8_MMA(0, 0, At, B0); PG8_BAR; PG8_SCHED;
            PG8_LDB(B1, 0, 1); PG8_STAGE(PG8_SB(0, 0), b2, voffB);
            PG8_BAR; PG8_WAIT_L(0); PG8_MMA(0, 1, At, B1); PG8_BAR;
            PG8_LDA(At, 0, 1); PG8_STAGE(PG8_SA(0, 0), a2, voffA);
            PG8_BAR; PG8_WAIT_L(0); PG8_MMA(1, 0, At, B0); PG8_BAR; PG8_SCHED;
            PG8_STAGE(PG8_SB(0, 1), b2 + hstep, voffB);
            PG8_WAIT_V(6); PG8_BAR; PG8_MMA(1, 1, At, B1); PG8_BAR;
            PG8_LDB(B0, 1, 0); PG8_SCHED; PG8_LDA(At, 1, 0); PG8_STAGE(PG8_SA(0, 1), a2 + hstep, voffA);
            PG8_WAIT_L(8); PG8_BAR; PG8_WAIT_L(0); PG8_MMA(0, 0, At, B0); PG8_BAR; PG8_SCHED;
            PG8_LDB(B1, 1, 1); PG8_STAGE(PG8_SB(1, 0), b3, voffB);
            PG8_BAR; PG8_WAIT_L(0); PG8_MMA(0, 1, At, B1); PG8_BAR;
            PG8_LDA(At, 1, 1); PG8_STAGE(PG8_SA(1, 0), a3, voffA);
            PG8_BAR; PG8_WAIT_L(0); PG8_MMA(1, 0, At, B0); PG8_BAR; PG8_SCHED;
            PG8_STAGE(PG8_SB(1, 1), b3 + hstep, voffB);
            PG8_WAIT_V(6); PG8_BAR; PG8_MMA(1, 1, At, B1); PG8_BAR;
            }
        }
        if constexpr (ALIGN_EPI) { if (wr == 0) PG8_BAR; }
        if constexpr (!Epi::AFTER_DRAIN) { E(acc, cur, wr, wc, fr, fq); S.done(cur); }
        if (!has_next) break;
#pragma unroll
        for (int a = 0; a < 2; ++a)
#pragma unroll
            for (int b = 0; b < 2; ++b)
#pragma unroll
                for (int m = 0; m < 4; ++m)
#pragma unroll
                    for (int n = 0; n < 2; ++n) acc[a][b][m][n] = (f32x4){0.f, 0.f, 0.f, 0.f};
        cur = nxt; cA = nA; cB = nB; ++ui;
        if constexpr (ALIGN_EPI) { if (wr == 1) PG8_BAR; }
    }
    PG8_WAIT_V(0);
    if constexpr (!ALIGN_EPI) { if (wr == 0) PG8_BAR; }
    PG8_BAR;
    if constexpr (Epi::AFTER_DRAIN) { E.fused(acc, cur, wr, wc, fr, fq, lds, wid, lane); S.done(cur); }
#undef PG8_SA
#undef PG8_SB
#undef PG8_STAGE
#undef PG8_LDA
#undef PG8_LDB
#undef PG8_MMA
#undef PG8_WAIT_V
#undef PG8_WAIT_L
#undef PG8_BAR
#undef PG8_SCHED
}
}
namespace attn_body {
using bf16=__hip_bfloat16;
using bf16x8=__attribute__((ext_vector_type(8)))short;
using s16x4=__attribute__((ext_vector_type(4)))short;
using f32x16=__attribute__((ext_vector_type(16)))float;
using u32x4=__attribute__((ext_vector_type(4)))unsigned;
using f32x4v=__attribute__((ext_vector_type(4)))float;
constexpr int BATCH=8,NHEAD=8,SEQ=4096,D=64,QP=1536,KP=512;
constexpr int NW=8,QBLK=32,QB=QBLK*NW,KVBLK=64,NQB=SEQ/QB;
constexpr int ATTN_UNIT_ROWS=QB;
__device__ __forceinline__ int crow(int r,int hi){return (r&3)+8*(r>>2)+4*hi;}
#define SBAR() __builtin_amdgcn_sched_barrier(0)
__device__ __forceinline__ void cmask(f32x16&p0,f32x16&p1,int jb,int qrel,int hi){
  const float NEG=-INFINITY; int kb=64*jb+4*hi;
  #pragma unroll
  for(int r=0;r<16;++r){int kv=kb+(r&3)+8*(r>>2); if(kv>qrel)p0[r]=NEG; if(kv+32>qrel)p1[r]=NEG;}
}

constexpr int NSLOT=3, SLOTB=8192;
constexpr int LDS_K=0, LDS_V=NSLOT*SLOTB, LDS_WS=2*NSLOT*SLOTB, LDS_OST=LDS_WS+NW*64*4, LDS_BIAS=LDS_OST+NW*4096, LDS_BYTES=LDS_BIAS+SEQ*4;
constexpr float C2=0.125f*1.4426950408889634f;
__device__ __forceinline__ void glds16(const void*gsrc,unsigned lds_dst){unsigned keep;
  asm volatile("s_mov_b32 %0, m0\n\ts_mov_b32 m0, %2\n\ts_nop 0\n\tglobal_load_lds_dwordx4 %1, off\n\ts_mov_b32 m0, %0":"=&s"(keep):"v"(gsrc),"s"(lds_dst):"memory");}
__device__ __forceinline__ float max3f(float a,float b,float c){float r;asm("v_max3_f32 %0, %1, %2, %3":"=v"(r):"v"(a),"v"(b),"v"(c));return r;}
__device__ __forceinline__ float max2f(float a,float b){float r;asm("v_max_f32_e32 %0, %1, %2":"=v"(r):"v"(a),"v"(b));return r;}
__device__ __forceinline__ float fadd_s(float a,float b){float r;asm("v_add_f32_e32 %0, %1, %2":"=v"(r):"v"(a),"v"(b));return r;}
__device__ __forceinline__ float fsub_s(float a,float b){float r;asm("v_sub_f32_e32 %0, %1, %2":"=v"(r):"v"(a),"v"(b));return r;}
typedef float f32x2_t __attribute__((ext_vector_type(2))); typedef __bf16 bf16x2_t __attribute__((ext_vector_type(2)));
__device__ __forceinline__ unsigned cvtpk_s(float lo,float hi){f32x2_t v={lo,hi};bf16x2_t b=__builtin_convertvector(v,bf16x2_t);return __builtin_bit_cast(unsigned,b);}
#define WAIT_BAR(N) asm volatile("s_waitcnt vmcnt(" #N ") lgkmcnt(0)\n\ts_barrier":::"memory")

__device__ __forceinline__ void qkt(f32x16&p0,f32x16&p1,const char*Kslot,const bf16x8*qr,int r32,int hi){
  const char*kb=Kslot+hi*1024+r32*16;
  #pragma unroll
  for(int d0=0;d0<4;++d0){
    const bf16x8 b0=*reinterpret_cast<const bf16x8*>(kb+d0*2048);
    const bf16x8 b1=*reinterpret_cast<const bf16x8*>(kb+d0*2048+512);
    p0=__builtin_amdgcn_mfma_f32_32x32x16_bf16(b0,qr[d0],p0,0,0,0);p1=__builtin_amdgcn_mfma_f32_32x32x16_bf16(b1,qr[d0],p1,0,0,0);}
}
typedef __attribute__((address_space(3))) const char* lds_cptr;
typedef short v4i16_t __attribute__((ext_vector_type(4)));
__device__ __forceinline__ void kload8(bf16x8*kf,lds_cptr kp){
  kf[0]=*(const __attribute__((address_space(3))) bf16x8*)(kp);      kf[1]=*(const __attribute__((address_space(3))) bf16x8*)(kp+512);
  kf[2]=*(const __attribute__((address_space(3))) bf16x8*)(kp+2048); kf[3]=*(const __attribute__((address_space(3))) bf16x8*)(kp+2560);
  kf[4]=*(const __attribute__((address_space(3))) bf16x8*)(kp+4096); kf[5]=*(const __attribute__((address_space(3))) bf16x8*)(kp+4608);
  kf[6]=*(const __attribute__((address_space(3))) bf16x8*)(kp+6144); kf[7]=*(const __attribute__((address_space(3))) bf16x8*)(kp+6656);
}
__device__ __forceinline__ void kload2(bf16x8*kf,lds_cptr kp,int j){ kf[2*j]=*(const __attribute__((address_space(3))) bf16x8*)(kp+j*2048); kf[2*j+1]=*(const __attribute__((address_space(3))) bf16x8*)(kp+j*2048+512); }
__device__ __forceinline__ s16x4 vtr(lds_cptr p){ return __builtin_bit_cast(s16x4,__builtin_amdgcn_ds_read_tr16_b64_v4i16((__attribute__((address_space(3))) v4i16_t*)p)); }
__device__ __forceinline__ float rowmax(const f32x16&p0,const f32x16&p1){
  float a=max3f(p0[0],p0[1],p1[0]),b=max3f(p0[2],p0[3],p1[1]);a=max3f(a,p1[2],p1[3]);
  #pragma unroll
  for(int r=4;r<16;r+=4){a=max3f(a,p0[r],p0[r+1]);b=max3f(b,p0[r+2],p0[r+3]);a=max3f(a,p1[r],p1[r+1]);b=max3f(b,p1[r+2],p1[r+3]);}
  const float m=max2f(a,b);
  auto rr=__builtin_amdgcn_permlane32_swap(__float_as_uint(m),__float_as_uint(m),false,false);
  return max2f(__uint_as_float(rr[0]),__uint_as_float(rr[1]));
}
__device__ __forceinline__ void pv(f32x16*o,int vb,bf16x8 pa0,bf16x8 pa1,bf16x8 pa2,bf16x8 pa3){
  #pragma unroll
  for(int d0=0;d0<2;++d0){s16x4 lo[4],hi[4];
    #pragma unroll
    for(int ks=0;ks<4;++ks){
      asm volatile("ds_read_b64_tr_b16 %0,%1 offset:%c2":"=&v"(lo[ks]):"v"(vb),"i"(d0*4096+ks*1024):"memory");
      asm volatile("ds_read_b64_tr_b16 %0,%1 offset:%c2":"=&v"(hi[ks]):"v"(vb),"i"(d0*4096+ks*1024+512):"memory");}
    asm volatile("s_waitcnt lgkmcnt(0)":::"memory");SBAR();
    #define PK(k) (bf16x8){lo[k][0],lo[k][1],lo[k][2],lo[k][3],hi[k][0],hi[k][1],hi[k][2],hi[k][3]}
    o[d0]=__builtin_amdgcn_mfma_f32_32x32x16_bf16(pa0,PK(0),o[d0],0,0,0);
    o[d0]=__builtin_amdgcn_mfma_f32_32x32x16_bf16(pa1,PK(1),o[d0],0,0,0);
    o[d0]=__builtin_amdgcn_mfma_f32_32x32x16_bf16(pa2,PK(2),o[d0],0,0,0);
    o[d0]=__builtin_amdgcn_mfma_f32_32x32x16_bf16(pa3,PK(3),o[d0],0,0,0);
    #undef PK
  }
}

#ifndef ATTN_STORE16
#define ATTN_STORE16(p,v) (*(u32x4*)(p)=(v))
#endif
template<int THRL> __device__ __forceinline__ void attn_unit(int b,int h,int qb,const bf16*Q,const bf16*__restrict__ K,const bf16*__restrict__ V,bf16*O,const float*__restrict__ nbias,char*shm){
  int tid_=threadIdx.x; asm volatile("":"+v"(tid_)); const int tid=tid_,lane=tid&63,r32=lane&31,hi=lane>>5; const int wid=__builtin_amdgcn_readfirstlane(tid>>6);
  const long rowbase=(long)b*SEQ; const int q0=qb*QB;
  { typedef __attribute__((address_space(3))) float* lfp; const lfp bl=(lfp)((__attribute__((address_space(3))) char*)shm+LDS_BIAS);
    for(int i=tid*4;i<q0+QB;i+=NW*64*4){ const f32x4v v=*reinterpret_cast<const f32x4v*>(nbias+i); *(__attribute__((address_space(3))) f32x4v*)(bl+i)=v; } }
  const bf16*Qw=Q+(rowbase+q0+wid*QBLK)*QP+h*D;
  const bf16*Kh=K+rowbase*KP+h*D,*Vh=V+rowbase*KP+h*D;
  const unsigned lds0=(unsigned)(uintptr_t)shm;
  float*wsf=(float*)(shm+LDS_WS)+wid*64;
  const bf16*ksrc=Kh+(long)lane*KP+wid*8;
  const bf16*vsrc=Vh+(long)(16*(wid&3)+(lane>>2))*KP+(wid>>2)*32+(lane&3)*8;
  const unsigned kdst=lds0+LDS_K+wid*1024, vdst=lds0+LDS_V+wid*1024;
  #define DMA_K(t,slot) glds16(ksrc+(long)(t)*KVBLK*KP,(unsigned)__builtin_amdgcn_readfirstlane(kdst+(slot)))
  #define DMA_V(t,slot) glds16(vsrc+(long)(t)*KVBLK*KP,(unsigned)__builtin_amdgcn_readfirstlane(vdst+(slot)))
  const int vb0=(int)(lds0+LDS_V)+((lane>>4)&1)*32+(lane&3)*8+(4*hi+((lane&15)>>2))*64;
  const char*Kbase=shm+LDS_K; bf16x8 kf[8];
  const lds_cptr shm3=(lds_cptr)shm; const lds_cptr kp0=shm3+LDS_K+hi*1024+r32*16; const lds_cptr vp0=shm3+LDS_V+((lane>>4)&1)*32+(lane&3)*8+(4*hi+((lane&15)>>2))*64;
  const int NT=(q0+QB)/KVBLK;
  DMA_K(0,0);DMA_V(0,0);DMA_K(1,SLOTB);
  bf16x8 qr[4];
  #pragma unroll
  for(int d0=0;d0<4;++d0)qr[d0]=*reinterpret_cast<const bf16x8*>(&Qw[(long)r32*QP+d0*16+hi*8]);
  float mhat=0.f,l_reg=0.f;f32x16 o[2];o[0]=f32x16{};o[1]=f32x16{};
  const int qrel=wid*QBLK+r32;
  #define CMASK(P0,P1,t) do{int jb_=(t)-(NT-4); if(jb_>=0)cmask(P0,P1,jb_,qrel,hi);}while(0)
  const __attribute__((address_space(3))) f32x4v* bias4=(const __attribute__((address_space(3))) f32x4v*)((__attribute__((address_space(3))) char*)shm+LDS_BIAS)+hi;
  #define INITC(P0,P1,t) do{ _Pragma("unroll") for(int a_=0;a_<4;++a_){ const f32x4v v0_=bias4[16*(t)+2*a_], v1_=bias4[16*(t)+8+2*a_]; \
      _Pragma("unroll") for(int b_=0;b_<4;++b_){ P0[4*a_+b_]=v0_[b_]-mhat; P1[4*a_+b_]=v1_[b_]-mhat; } } }while(0)
  bool resc=false;
  #define START(P0,P1) do{ const float rm=rowmax(P0,P1); resc=false; \
    { const float dl=rm; mhat=fadd_s(mhat,dl); \
      _Pragma("unroll") for(int r=0;r<16;++r){P0[r]=fsub_s(P0[r],dl);P1[r]=fsub_s(P1[r],dl);} \
      } \
    _Pragma("unroll") for(int r=0;r<16;++r)P0[r]=__builtin_amdgcn_exp2f(P0[r]); }while(0)
  #define RESC() do{ if(resc){ asm volatile("s_waitcnt lgkmcnt(0)":::"memory"); \
      _Pragma("unroll") for(int d_=0;d_<2;++d_) _Pragma("unroll") for(int r=0;r<16;++r)o[d_][r]*=wsf[crow(r,hi)]; } }while(0)
  f32x16 pA0,pA1,pB0,pB1;
  int sl_prev=0,sl_cur=0,sl_next=SLOTB;
  #define ROT() do{sl_prev=sl_cur;sl_cur=sl_next;sl_next=(sl_next==(NSLOT-1)*SLOTB)?0:sl_next+SLOTB;}while(0)
  DMA_K(2,2*SLOTB);
  WAIT_BAR(3);
  INITC(pA0,pA1,0);qkt(pA0,pA1,Kbase,qr,r32,hi);asm volatile("s_nop 15\n\ts_nop 7":"+v"(pA0),"+v"(pA1));CMASK(pA0,pA1,0);
  START(pA0,pA1);
  _Pragma("unroll") for(int r=0;r<16;++r)pA1[r]=__builtin_amdgcn_exp2f(pA1[r]);
  WAIT_BAR(0);
  DMA_K(3,0);DMA_V(1,SLOTB);
  ROT();
  kload8(kf,kp0+sl_cur);
  WAIT_BAR(2);
  s16x4 vlo[8],vhi[8]; u32x4 pw0,pw1,pw2,pw3;
  #define PKW(P,B) cvtpk_s(P[B],P[B+1])
  #define PAF(k) __builtin_bit_cast(bf16x8,pw##k)
  #define VFR(i) (bf16x8){vlo[i][0],vlo[i][1],vlo[i][2],vlo[i][3],vhi[i][0],vhi[i][1],vhi[i][2],vhi[i][3]}
  #define PIN(x) asm volatile("":"+v"(x))
  #define MX3(a,b,c) __builtin_fmaxf(__builtin_fmaxf((a),(b)),(c))
  #define GAPA(MF,A0,A1,A2,A3,W0,W1,PW) do{ MF; sacc+=A0; sacc+=A1; sacc+=A2; sacc+=A3; PIN(sacc); W0; W1; PIN(PW); SBAR(); }while(0)
  #define EX(v) __builtin_amdgcn_exp2f(v)
  #define GAPB(MF,X,B) do{ MF; X[B]=EX(X[B]); X[B+1]=EX(X[B+1]); X[B+2]=EX(X[B+2]); X[B+3]=EX(X[B+3]); PIN(X); SBAR(); }while(0)
  #define VRD(i) do{ vlo[i]=vtr(vp_+(((i)>>2)*4096+((i)&3)*1024)); vhi[i]=vtr(vp_+(((i)>>2)*4096+((i)&3)*1024+512)); }while(0)
  #define KRD(G,j) do{ if(G){ kload2(kf,kp0+sl_next,j); SBAR(); } }while(0)
  #define STEP(C0,C1,P0,P1,t,GK,GV,GL) do{ SBAR(); INITC(C0,C1,t); SBAR(); \
    const lds_cptr vp_=vp0+sl_prev; \
    VRD(0); SBAR(); float sacc=(P0[0]+P0[1]); \
    GAPA(C0=__builtin_amdgcn_mfma_f32_32x32x16_bf16(kf[0],qr[0],C0,0,0,0), P0[2],P0[3],P0[4],P0[5],     pw0[0]=PKW(P0,0), pw0[1]=PKW(P0,2), pw0); \
    VRD(4); SBAR(); GAPA(C1=__builtin_amdgcn_mfma_f32_32x32x16_bf16(kf[1],qr[0],C1,0,0,0), P0[6],P0[7],P0[8],P0[9],     pw0[2]=PKW(P0,4), pw0[3]=PKW(P0,6), pw0); \
    VRD(1); SBAR(); GAPA(C0=__builtin_amdgcn_mfma_f32_32x32x16_bf16(kf[2],qr[1],C0,0,0,0),   P0[10],P0[11],P0[12],P0[13], pw1[0]=PKW(P0,8), pw1[1]=PKW(P0,10), pw1); \
    VRD(5); SBAR(); GAPA(C1=__builtin_amdgcn_mfma_f32_32x32x16_bf16(kf[3],qr[1],C1,0,0,0),   P0[14],P0[15],P1[0],P1[1],   pw1[2]=PKW(P0,12),pw1[3]=PKW(P0,14), pw1); \
    VRD(2); SBAR(); GAPA(C0=__builtin_amdgcn_mfma_f32_32x32x16_bf16(kf[4],qr[2],C0,0,0,0),   P1[2],P1[3],P1[4],P1[5],     pw2[0]=PKW(P1,0), pw2[1]=PKW(P1,2), pw2); \
    VRD(6); SBAR(); GAPA(C1=__builtin_amdgcn_mfma_f32_32x32x16_bf16(kf[5],qr[2],C1,0,0,0),   P1[6],P1[7],P1[8],P1[9],     pw2[2]=PKW(P1,4), pw2[3]=PKW(P1,6), pw2); \
    VRD(3); SBAR(); GAPA(C0=__builtin_amdgcn_mfma_f32_32x32x16_bf16(kf[6],qr[3],C0,0,0,0),   P1[10],P1[11],P1[12],P1[13], pw3[0]=PKW(P1,8), pw3[1]=PKW(P1,10), pw3); \
    VRD(7); SBAR(); GAPA(C1=__builtin_amdgcn_mfma_f32_32x32x16_bf16(kf[7],qr[3],C1,0,0,0),   P1[14],P1[15],0.f,0.f,       pw3[2]=PKW(P1,12),pw3[3]=PKW(P1,14), pw3); \
    l_reg+=sacc; \
    if(GK){DMA_K((t)+3,sl_cur);} if(GV){DMA_V((t)+1,sl_next);} \
    CMASK(C0,C1,t); \
    { float a=MX3(C0[0],C0[1],C1[0]),b=MX3(C0[2],C0[3],C1[1]); a=MX3(a,C1[2],C1[3]); \
      _Pragma("unroll") for(int r=4;r<16;r+=4){a=MX3(a,C0[r],C0[r+1]);b=MX3(b,C0[r+2],C0[r+3]);a=MX3(a,C1[r],C1[r+1]);b=MX3(b,C1[r+2],C1[r+3]);} \
      float rm=__builtin_fmaxf(a,b); { auto rr=__builtin_amdgcn_permlane32_swap(__float_as_uint(rm),__float_as_uint(rm),false,false); rm=__builtin_fmaxf(__uint_as_float(rr[0]),__uint_as_float(rr[1])); } \
      resc=false; \
      if(__builtin_expect(__any(rm>(float)THRL),0)){ const float dl=__builtin_fmaxf(rm,0.f); mhat+=dl; \
        _Pragma("unroll") for(int r=0;r<16;++r){C0[r]-=dl;C1[r]-=dl;} \
        const float f=__builtin_amdgcn_exp2f(-dl); l_reg*=f; if(hi==0)wsf[r32]=f; resc=true; } } \
    SBAR(); \
    GAPB(o[0]=__builtin_amdgcn_mfma_f32_32x32x16_bf16(PAF(0),VFR(0),o[0],0,0,0), C0,0); \
    GAPB(o[1]=__builtin_amdgcn_mfma_f32_32x32x16_bf16(PAF(0),VFR(4),o[1],0,0,0), C0,4); \
    KRD(GL,0); GAPB(o[0]=__builtin_amdgcn_mfma_f32_32x32x16_bf16(PAF(1),VFR(1),o[0],0,0,0), C0,8); \
    KRD(GL,1); GAPB(o[1]=__builtin_amdgcn_mfma_f32_32x32x16_bf16(PAF(1),VFR(5),o[1],0,0,0), C0,12); \
    KRD(GL,2); GAPB(o[0]=__builtin_amdgcn_mfma_f32_32x32x16_bf16(PAF(2),VFR(2),o[0],0,0,0), C1,0); \
    KRD(GL,3); GAPB(o[1]=__builtin_amdgcn_mfma_f32_32x32x16_bf16(PAF(2),VFR(6),o[1],0,0,0), C1,4); \
    GAPB(o[0]=__builtin_amdgcn_mfma_f32_32x32x16_bf16(PAF(3),VFR(3),o[0],0,0,0), C1,8); \
    GAPB(o[1]=__builtin_amdgcn_mfma_f32_32x32x16_bf16(PAF(3),VFR(7),o[1],0,0,0), C1,12); \
    }while(0)
  int t=1;
  #undef CMASK
  #define CMASK(P0,P1,t) do{}while(0)
  for(;t+5<NT;t+=2){
    STEP(pB0,pB1,pA0,pA1,t,true,true,true);     WAIT_BAR(2); RESC(); ROT();
    STEP(pA0,pA1,pB0,pB1,t+1,true,true,true);   WAIT_BAR(2); RESC(); ROT();
  }
  #undef CMASK
  #define CMASK(P0,P1,t) do{int jb_=(t)-(NT-4); if(jb_>=0)cmask(P0,P1,jb_,qrel,hi);}while(0)
  #define ENDW(tt) do{ if((tt)+3<NT){WAIT_BAR(2);} else if((tt)+2<NT){WAIT_BAR(1);} else {WAIT_BAR(0);} }while(0)
  for(;t+1<NT;t+=2){
    STEP(pB0,pB1,pA0,pA1,t,(t+3<NT),(t+1<NT),(t+1<NT));       ENDW(t);   RESC(); ROT();
    STEP(pA0,pA1,pB0,pB1,t+1,(t+4<NT),(t+2<NT),(t+2<NT));     ENDW(t+1); RESC(); ROT();
  }
  STEP(pB0,pB1,pA0,pA1,NT-1,false,false,false); RESC();
  { float sacc=pB0[0]+pB0[1]; _Pragma("unroll") for(int r=2;r<16;++r)sacc+=pB0[r]; _Pragma("unroll") for(int r=0;r<16;++r)sacc+=pB1[r]; l_reg+=sacc;
    pw0=(u32x4){PKW(pB0,0),PKW(pB0,2),PKW(pB0,4),PKW(pB0,6)};pw1=(u32x4){PKW(pB0,8),PKW(pB0,10),PKW(pB0,12),PKW(pB0,14)};pw2=(u32x4){PKW(pB1,0),PKW(pB1,2),PKW(pB1,4),PKW(pB1,6)};pw3=(u32x4){PKW(pB1,8),PKW(pB1,10),PKW(pB1,12),PKW(pB1,14)};
    SBAR(); pv(o,vb0+sl_cur,PAF(0),PAF(1),PAF(2),PAF(3)); }
  #undef PKW
  #undef PAF
  #undef VFR
  #undef PIN
  #undef MX3
  #undef GAPA
  #undef GAPB
  #undef EX
  #undef VRD
  #undef KRD
  #undef STEP
  #undef ENDW
  {auto rr=__builtin_amdgcn_permlane32_swap(__float_as_uint(l_reg),__float_as_uint(l_reg),false,false);l_reg=__uint_as_float(rr[0])+__uint_as_float(rr[1]);}
  if(hi==0)wsf[32+r32]=l_reg;asm volatile("s_waitcnt lgkmcnt(0)":::"memory");
  float rli[16];
  #pragma unroll
  for(int r=0;r<16;++r)rli[r]=__builtin_amdgcn_rcpf(wsf[32+crow(r,hi)]);
  bf16*Ow=O+(rowbase+q0+wid*QBLK)*QP+h*D;
  { bf16*stg=(bf16*)(shm+LDS_OST)+wid*2048;
    #pragma unroll
    for(int r=0;r<16;++r){const int orow=crow(r,hi);
      #pragma unroll
      for(int d0=0;d0<2;++d0)stg[orow*64+d0*32+r32]=__float2bfloat16(o[d0][r]*rli[r]);}
    asm volatile("s_waitcnt lgkmcnt(0)":::"memory");
    #pragma unroll
    for(int i=0;i<4;++i){const int row=i*8+(lane>>3),ch=lane&7; const u32x4 v=*(const u32x4*)(stg+row*64+ch*8); ATTN_STORE16(Ow+(long)row*QP+ch*8,v);} }
  asm volatile("s_waitcnt lgkmcnt(0)\n\ts_barrier":::"memory");
  #undef DMA_K
  #undef DMA_V
  #undef CMASK
  #undef INITC
  #undef START
  #undef RESC
  #undef ROT
}
constexpr int ATTN_LDS_BYTES=LDS_BYTES;
struct AttnTensors { const bf16* Q; const bf16* K; const bf16* V; bf16* O; const float* nbias; };
template<int THRL=8> __device__ __forceinline__ void attn_phase(char*lds,const AttnTensors&T,int vcu,int G){
  for(int v=vcu;v<256;v+=G){ const int s=v&3,bh=v>>2;
    for(int i=0;i<4;++i){ const int qb=(i==0)?s:(i==1)?7-s:(i==2)?8+s:15-s;
      attn_unit<THRL>(bh/NHEAD,bh%NHEAD,qb,T.Q,T.K,T.V,T.O,T.nbias+(long)bh*SEQ,lds); } }
}
#undef SBAR
#undef WAIT_BAR
}
#define GAS __attribute__((address_space(1)))
#define LAS __attribute__((address_space(3)))
typedef unsigned short bf16;
typedef unsigned v4u __attribute__((ext_vector_type(4)));
typedef float f32x4 __attribute__((ext_vector_type(4)));
typedef short bf16x8 __attribute__((ext_vector_type(8)));
typedef GAS unsigned gu32;
typedef GAS unsigned long long gu64;
#define RLX_AGENT __ATOMIC_RELAXED, __HIP_MEMORY_SCOPE_AGENT
#define LDS_WAIT() asm volatile("s_waitcnt lgkmcnt(0)" ::: "memory")
#define VM_WAIT() asm volatile("s_waitcnt vmcnt(0)" ::: "memory")
__device__ __forceinline__ unsigned long long rt() { return __builtin_amdgcn_s_memrealtime(); }
__device__ __forceinline__ unsigned f2bf(float f) { unsigned u = __builtin_bit_cast(unsigned, f); return (u + 0x7fffu + ((u >> 16) & 1u)) >> 16; }
__device__ __forceinline__ unsigned pk2(float lo, float hi) { return f2bf(lo) | (f2bf(hi) << 16); }

#define XB_TMO      128
#define XB_XCNT(j)  (256  + 64 * (j))
#define XB_XSUB(j)  (1280 + 64 * (j))
#define XB_XGEN(j)  (2304 + 64 * (j))
#define XB_TOP      3328
#define XB_TOPGEN   3392
#define XCD_BAR_WORDS 3456
#define XB_SPIN_CAP (1u << 18)

__device__ __forceinline__ unsigned xb_ld(unsigned* p)              { return __hip_atomic_load(p, __ATOMIC_RELAXED, __HIP_MEMORY_SCOPE_AGENT); }
__device__ __forceinline__ unsigned xb_add(unsigned* p, unsigned v) { return __hip_atomic_fetch_add(p, v, __ATOMIC_RELAXED, __HIP_MEMORY_SCOPE_AGENT); }
__device__ __forceinline__ unsigned xb_xcc_id() { return (unsigned)__builtin_amdgcn_s_getreg((3 << 11) | 20) & 0xFu; }
#define XB_SPIN(cond, bar) do { unsigned _sp = 0; while (cond) { __builtin_amdgcn_s_sleep(1); \
    if ((++_sp & 255u) == 0u) { if (xb_ld(&(bar)[XB_TMO])) break; if (_sp > XB_SPIN_CAP) { atomicAdd(&(bar)[XB_TMO], 1u); break; } } } } while (0)

struct XcdBarrier {
    unsigned* bar; unsigned x;
    volatile LAS unsigned* st;
};

__device__ __forceinline__ XcdBarrier xcd_barrier_post(unsigned* bar, volatile LAS unsigned* st) {
    XcdBarrier b; b.bar = bar; b.x = xb_xcc_id(); b.st = st;
    if (threadIdx.x == 0) (void)xb_add(&bar[XB_XCNT(b.x)], 1u);
    return b;
}
__device__ __forceinline__ void xcd_barrier_complete(unsigned* bar, unsigned x, unsigned& nloc, unsigned& nx) {
    const unsigned G = gridDim.x * gridDim.y * gridDim.z;
    unsigned sum, cnt, mine, sp = 0u;
    for (;;) {
        sum = 0u; cnt = 0u; mine = 0u;
#pragma unroll
        for (unsigned j = 0; j < 16; ++j) { const unsigned c = xb_ld(&bar[XB_XCNT(j)]); sum += c; cnt += (c > 0u) ? 1u : 0u; mine = (j == x) ? c : mine; }
        if (sum == G) break;
        __builtin_amdgcn_s_sleep(1);
        if ((++sp & 255u) == 0u) { if (xb_ld(&bar[XB_TMO])) break; if (sp > XB_SPIN_CAP) { atomicAdd(&bar[XB_TMO], 1u); break; } }
    }
    nloc = mine > 0u ? mine : 1u; nx = cnt > 0u ? cnt : 1u;
}

__device__ __forceinline__ void xcd_barrier(const XcdBarrier& b) {
    asm volatile("s_waitcnt vmcnt(0)" ::: "memory");
    __syncthreads();
    if (threadIdx.x == 0) {
        unsigned* bar = b.bar;
        __builtin_amdgcn_s_waitcnt(0);
        unsigned nloc = b.st[0], nx = b.st[1];
        if (nloc == 0u) { xcd_barrier_complete(bar, b.x, nloc, nx); b.st[0] = nloc; b.st[1] = nx; }
        const unsigned old = xb_add(&bar[XB_XSUB(b.x)], 1u);
        const unsigned gen = old / nloc;
        if (old + 1u == (gen + 1u) * nloc) {
            __builtin_amdgcn_fence(__ATOMIC_RELEASE, "agent");
            asm volatile("s_waitcnt vmcnt(0)" ::: "memory");
            const unsigned og = xb_add(&bar[XB_TOP], 1u);
            const unsigned tg = og / nx;
            if (og + 1u == (tg + 1u) * nx) xb_add(&bar[XB_TOPGEN], 1u);
            else XB_SPIN(xb_ld(&bar[XB_TOPGEN]) == tg, bar);
            __builtin_amdgcn_fence(__ATOMIC_ACQUIRE, "agent");
            xb_add(&bar[XB_XGEN(b.x)], 1u);
            asm volatile("s_waitcnt vmcnt(0)" ::: "memory");
        } else {
            XB_SPIN(xb_ld(&bar[XB_XGEN(b.x)]) == gen, bar);
            __builtin_amdgcn_fence(__ATOMIC_ACQUIRE, "agent");
            asm volatile("s_waitcnt vmcnt(0)" ::: "memory");
        }
    }
    __syncthreads();
}
constexpr int NWAVES = 8;
#ifndef MK_PER_PHASE
#define MK_PER_PHASE 1
#endif

constexpr float K_LOG2E_F = 1.4426950408889634f;
constexpr int NB = 8, SEQ = 4096, D = 1024, M = NB * SEQ, DFF = 2816, DEPTH = 4;
constexpr int NGU = 2 * DFF;
constexpr int NIN = 3328;
constexpr int KOUT = 1536;
constexpr int IN_W = 2768;
constexpr int NPHASE = 2 + 8 * DEPTH;
constexpr size_t W_GU1 = 0, W_D1 = W_GU1 + (size_t)NGU * D, W_IN = W_D1 + (size_t)D * DFF, W_OUT = W_IN + (size_t)NIN * D, W_GU2 = W_OUT + (size_t)D * KOUT, W_D2 = W_GU2 + (size_t)NGU * D,
                 W_LAYER = W_D2 + (size_t)D * DFF;
constexpr size_t MiB = 1u << 20;
constexpr size_t WS_CTL = 0, CTL_ZERO_BYTES = 1 * MiB;
constexpr size_t WS_W = 2 * MiB;
constexpr size_t WS_HB = 172 * MiB;
constexpr size_t WS_SSQ = 236 * MiB;
constexpr size_t WS_IDX = 238 * MiB;
constexpr size_t WS_CUM = 254 * MiB;
constexpr size_t WS_BIG = 256 * MiB;
constexpr size_t WS_ATT = WS_BIG, WS_QI = WS_BIG + 96 * MiB, WS_FK = WS_BIG + 128 * MiB, WS_FV = WS_BIG + 160 * MiB, WS_CR = WS_BIG + 192 * MiB, WS_CKV = WS_BIG + 208 * MiB,
                 WS_KI = WS_BIG + 216 * MiB, WS_WI = WS_BIG + 220 * MiB, WS_FL = WS_BIG + 221 * MiB, WS_END = WS_BIG + 222 * MiB;
static_assert(WS_W + 4 * W_LAYER * 2 <= WS_HB && (size_t)M * DFF * 2 <= 222 * MiB, "d_ws map");
constexpr int CW_BAR = 4096;
constexpr int RING_OFF = 0, RING_BYTES = 135168;
constexpr int LUT_OFF = RING_BYTES;
constexpr int MISC_OFF = LUT_OFF + 8320;
constexpr int LDS_BYTES = MISC_OFF + 256;
static_assert(LDS_BYTES <= 163840, "LDS");

struct Params { const float* in[18]; float* out; unsigned char* ws; int ph_lo, ph_hi; };
struct Frame {
    LAS unsigned char* lds; int tid, lane, wave, vcu, G, bx;
};
__device__ __forceinline__ float wave_sum(float v) {
#pragma unroll
    for (int o = 1; o < 64; o <<= 1) v += __shfl_xor(v, o);
    return v;
}
__device__ __forceinline__ void tr_item(const float* __restrict__ W, int ldw, int k0, int c0, int mode, const float* __restrict__ gain, bf16* WT, int ldt, int n0, int dk0, LAS float* scr, int lane) {
    const int j = lane & 31;
    int col = c0 + j;
    if (mode == 1) col = (j < 8) ? (1216 + j) : (j < 16) ? (2760 + (j - 8)) : -1;
    else if (mode == 2) col = -1;
#pragma unroll 8
    for (int i = 0; i < 32; ++i) { const int kk = 2 * i + (lane >> 5); float v = 0.f;
        if (col >= 0) { v = W[(size_t)(k0 + kk) * ldw + col]; if (gain) v *= gain[k0 + kk]; }
        scr[kk * 33 + j] = v; }
    LDS_WAIT(); asm volatile("" ::: "memory");
    const int c = lane & 7;
#pragma unroll
    for (int jj = 0; jj < 4; ++jj) { const int n = (lane >> 3) + 8 * jj; const LAS float* s = scr + (8 * c) * 33 + n;
        v4u o; o.x = pk2(s[0 * 33], s[1 * 33]); o.y = pk2(s[2 * 33], s[3 * 33]); o.z = pk2(s[4 * 33], s[5 * 33]); o.w = pk2(s[6 * 33], s[7 * 33]);
        *(GAS v4u*)(WT + (size_t)(n0 + n) * ldt + dk0 + 8 * c) = o; }
    LDS_WAIT(); asm volatile("" ::: "memory");
}
constexpr int IT_FFN = 1408;
constexpr int IT_WIN = 72 * 16, IT_WOF = 32 * 8;
constexpr int IT_TR_LAYER = 6 * IT_FFN + IT_WIN + IT_WOF;
constexpr int IT_FOLD_LAYER = 256;
typedef const __attribute__((address_space(4))) Params* kparams_t;
__device__ __forceinline__ void prologue_phase(kparams_t P, Frame& F) {
    LAS float* scr = (LAS float*)(F.lds + RING_OFF + F.wave * 16384);
    const int gw = F.vcu * NWAVES + F.wave, NGW = F.G * NWAVES;
    bf16* Wall = (bf16*)(P->ws + WS_W);
    for (int it = gw; it < DEPTH * IT_FOLD_LAYER; it += NGW) {
        const int l = __builtin_amdgcn_readfirstlane(it / IT_FOLD_LAYER), r = __builtin_amdgcn_readfirstlane(it % IT_FOLD_LAYER);
        bf16* Wl = Wall + (size_t)l * W_LAYER;
        if (r < 128) {
            const int h = r >> 4, kb = r & 15, k = 64 * kb + F.lane;
            const float* src = P->in[6] + (size_t)l * D * IN_W + (size_t)k * IN_W + h * 64; const float gk = P->in[5][l * D + k];
#pragma unroll 4
            for (int d = 0; d < 64; d += 4) { const f32x4 v = *(const f32x4*)(src + d); scr[d * 64 + F.lane] = v[0] * gk; scr[(d + 1) * 64 + F.lane] = v[1] * gk; scr[(d + 2) * 64 + F.lane] = v[2] * gk; scr[(d + 3) * 64 + F.lane] = v[3] * gk; }
            LDS_WAIT(); asm volatile("" ::: "memory");
            const float* uk = P->in[9] + (size_t)l * 128 * 512 + h * 64;
            bf16* dst = Wl + W_IN + (size_t)(h * 128) * D + k;
#pragma unroll 1
            for (int c = 0; c < 128; ++c) { const float* ur = uk + (size_t)c * 512; float a = 0.f;
#pragma unroll 8
                for (int d = 0; d < 64; ++d) a += scr[d * 64 + F.lane] * ur[d];
                dst[(size_t)c * D] = (bf16)f2bf(a); }
            LDS_WAIT(); asm volatile("" ::: "memory");
        } else {
            const int rr = r - 128, h = rr >> 4, nb = rr & 15, n = 64 * nb + F.lane;
            const float* src = P->in[11] + (size_t)l * D * D + (size_t)(h * 64) * D + n;
#pragma unroll 4
            for (int d = 0; d < 64; ++d) scr[d * 64 + F.lane] = src[(size_t)d * D];
            LDS_WAIT(); asm volatile("" ::: "memory");
            const float* uv = P->in[10] + (size_t)l * 128 * 512 + h * 64;
            bf16* dst = Wl + W_OUT + (size_t)n * KOUT + h * 128;
#pragma unroll 1
            for (int c8 = 0; c8 < 128; c8 += 8) { float a0 = 0.f, a1 = 0.f, a2 = 0.f, a3 = 0.f, a4 = 0.f, a5 = 0.f, a6 = 0.f, a7 = 0.f; const float* ur = uv + (size_t)c8 * 512;
#pragma unroll 4
                for (int d = 0; d < 64; ++d) { const float o = scr[d * 64 + F.lane];
                    a0 += o * ur[d]; a1 += o * ur[512 + d]; a2 += o * ur[1024 + d]; a3 += o * ur[1536 + d]; a4 += o * ur[2048 + d]; a5 += o * ur[2560 + d]; a6 += o * ur[3072 + d]; a7 += o * ur[3584 + d]; }
                v4u o; o.x = pk2(a0, a1); o.y = pk2(a2, a3); o.z = pk2(a4, a5); o.w = pk2(a6, a7);
                *(GAS v4u*)(dst + c8) = o; }
            LDS_WAIT(); asm volatile("" ::: "memory");
        }
    }
    for (int it = gw; it < DEPTH * IT_TR_LAYER; it += NGW) {
        const int l = it / IT_TR_LAYER; int r = it % IT_TR_LAYER;
        bf16* Wl = Wall + (size_t)l * W_LAYER;
        if (r < 6 * IT_FFN) {
            const int f = r / (3 * IT_FFN); r -= f * 3 * IT_FFN;
            const int which = r / IT_FFN; r -= which * IT_FFN;
            const float* gain = P->in[f ? 12 : 1] + l * D;
            if (which < 2) { const int kb = r / 88, nb = r % 88;
                tr_item(P->in[(f ? 13 : 2) + which] + (size_t)l * D * DFF, DFF, 64 * kb, 32 * nb, 0, gain, Wl + (f ? W_GU2 : W_GU1), D, 256 * (nb >> 2) + 32 * (nb & 3) + 128 * which, 64 * kb, scr, F.lane); }
            else { const int kb = r / 32, nb = r % 32;
                tr_item(P->in[f ? 15 : 4] + (size_t)l * DFF * D, D, 64 * kb, 32 * nb, 0, nullptr, Wl + (f ? W_D2 : W_D1), DFF, 32 * nb, 64 * kb, scr, F.lane); }
            continue;
        }
        r -= 6 * IT_FFN;
        if (r < IT_WIN) { const int kb = r / 72, nb = r % 72; int c0 = 0, n0 = 0, mode = 0;
            if (nb < 16) { c0 = 640 + 32 * nb; n0 = 1024 + 32 * nb; }
            else if (nb < 64) { c0 = 1224 + 32 * (nb - 16); n0 = 1536 + 32 * (nb - 16); }
            else if (nb < 68) { c0 = 512 + 32 * (nb - 64); n0 = 3072 + 32 * (nb - 64); }
            else if (nb < 70) { c0 = 1152 + 32 * (nb - 68); n0 = 3200 + 32 * (nb - 68); }
            else if (nb == 70) { mode = 1; n0 = 3264; }
            else { mode = 2; n0 = 3296; }
            tr_item(P->in[6] + (size_t)l * D * IN_W, IN_W, 64 * kb, c0, mode, P->in[5] + l * D, Wl + W_IN, D, n0, 64 * kb, scr, F.lane);
            continue;
        }
        r -= IT_WIN;
        { const int kb = r / 32, nb = r % 32;
          tr_item(P->in[11] + (size_t)l * D * D, D, 512 + 64 * kb, 32 * nb, 0, nullptr, Wl + W_OUT, KOUT, 32 * nb, 1024 + 64 * kb, scr, F.lane); }
    }
    bf16* HB = (bf16*)(P->ws + WS_HB); float* SSQ = (float*)(P->ws + WS_SSQ);
    for (int m = gw; m < M; m += NGW) {
        const GAS f32x4* xr = (const GAS f32x4*)(P->in[0] + (size_t)m * D) + F.lane;
        f32x4 v[4]; float s = 0.f;
#pragma unroll
        for (int j = 0; j < 4; ++j) { v[j] = xr[64 * j]; s += (v[j].x * v[j].x + v[j].y * v[j].y) + (v[j].z * v[j].z + v[j].w * v[j].w); }
        s = wave_sum(s);
        GAS unsigned long long* o8 = (GAS unsigned long long*)(HB + (size_t)m * D) + F.lane;
#pragma unroll
        for (int j = 0; j < 4; ++j) o8[64 * j] = (unsigned long long)pk2(v[j].x, v[j].y) | ((unsigned long long)pk2(v[j].z, v[j].w) << 32);
        if (F.lane < 16) SSQ[(size_t)m * 16 + F.lane] = (F.lane == 0) ? s : 0.f;
    }
}
typedef unsigned short u16;
typedef unsigned u32x4t __attribute__((ext_vector_type(4)));
constexpr int TOPK = 256;
__device__ __forceinline__ void scan_unit(const float* FL, const float* bfg, float* CUM, int bh, Frame& F) {
    const int b = bh >> 3, h = bh & 7; const float bf = bfg[h];
    const float* src = FL + ((size_t)b * SEQ + 8 * F.tid) * 8 + h;
    float pre[8]; float run = 0.f;
#pragma unroll
    for (int e = 0; e < 8; ++e) { const float x = src[e * 8] + bf; const float lf = fminf(x, 0.f) - log1pf(expf(-fabsf(x))); run += lf; pre[e] = run; }
    float inc = run;
#pragma unroll
    for (int o = 1; o < 64; o <<= 1) { const float t = __shfl_up(inc, o); if (F.lane >= o) inc += t; }
    LAS float* wt = (LAS float*)(F.lds + RING_OFF);
    __syncthreads();
    if (F.lane == 63) wt[F.wave] = inc;
    __syncthreads();
    float off = inc - run;
    for (int w = 0; w < F.wave; ++w) off += wt[w];
    float* dst = CUM + (size_t)bh * SEQ + 8 * F.tid;
    f32x4 o0, o1;
    o0[0] = -K_LOG2E_F * (off + pre[0]); o0[1] = -K_LOG2E_F * (off + pre[1]); o0[2] = -K_LOG2E_F * (off + pre[2]); o0[3] = -K_LOG2E_F * (off + pre[3]);
    o1[0] = -K_LOG2E_F * (off + pre[4]); o1[1] = -K_LOG2E_F * (off + pre[5]); o1[2] = -K_LOG2E_F * (off + pre[6]); o1[3] = -K_LOG2E_F * (off + pre[7]);
    *(f32x4*)dst = o0; *(f32x4*)(dst + 4) = o1;
    __syncthreads();
}
__device__ __forceinline__ void ckv_rows(const float* CR, const float* g, bf16* CKV, Frame& F) {
    const int gw = F.vcu * NWAVES + F.wave, NGW = F.G * NWAVES;
    const float g0 = g[2 * F.lane], g1 = g[2 * F.lane + 1];
    for (int m = gw; m < M; m += NGW) {
        const float v0 = CR[(size_t)m * 128 + 2 * F.lane], v1 = CR[(size_t)m * 128 + 2 * F.lane + 1];
        const float ss = wave_sum(v0 * v0 + v1 * v1); const float rs = 1.0f / sqrtf(ss * (1.0f / 128.0f) + 1e-6f);
        *(GAS unsigned*)(CKV + (size_t)m * 128 + 2 * F.lane) = pk2(v0 * rs * g0, v1 * rs * g1);
    }
}
__device__ __forceinline__ void topk_unit(const bf16* QI, const bf16* KI, const float* WI, u16* IDX, int b, int u, Frame& F) {
    const int lane = F.lane, wave = F.wave, tid = F.tid;
    const int t0 = 16 * u, tA = t0 + 2 * wave, half = lane >> 5, keyl = lane & 31;
    LAS unsigned char* kbuf = F.lds + RING_OFF;
    LAS u16* ost = (LAS u16*)(F.lds + RING_OFF + 32768 + wave * 1024);
    if (t0 < TOPK) {
        u32x4t v; const unsigned k0 = 8u * (unsigned)keyl;
        v.x = k0 | ((k0 + 1) << 16); v.y = (k0 + 2) | ((k0 + 3) << 16); v.z = (k0 + 4) | ((k0 + 5) << 16); v.w = (k0 + 6) | ((k0 + 7) << 16);
        *(GAS u32x4t*)(IDX + ((size_t)b * SEQ + tA + half) * TOPK + 8 * keyl) = v;
        return;
    }
    const int nch = (t0 + 16 + 127) >> 7;
    const int m16 = lane & 15, g = lane >> 4;
    const bf16* qrow = QI + ((size_t)b * SEQ + tA + (m16 >> 3)) * 512 + (m16 & 7) * 64 + 8 * g;
    const bf16x8 a0 = *(const bf16x8*)qrow, a1 = *(const bf16x8*)(qrow + 32);
    const f32x4 wv = *(const f32x4*)(WI + ((size_t)b * SEQ + tA + (g >> 1)) * 8 + 4 * (g & 1));
    const int tq = tA + half;
    float sc[128];
    float vmin = INFINITY, vmax = -INFINITY;
    const GAS u32x4t* ksrc = (const GAS u32x4t*)(KI + (size_t)b * SEQ * 64);
#define KU_ADDR(i) ((((i) >> 3) * 128) + ((((i) & 7) ^ (((i) >> 3) & 7)) * 16))
    const GAS u32x4t* kp0 = ksrc + tid; const GAS u32x4t* kp1 = ksrc + 512 + tid;
    u32x4t r0 = *kp0, r1 = *kp1;
    *(LAS u32x4t*)(kbuf + KU_ADDR(tid)) = r0; *(LAS u32x4t*)(kbuf + KU_ADDR(512 + tid)) = r1;
    __syncthreads();
#pragma unroll
    for (int c = 0; c < 32; ++c) {
        if (c < nch) {
            if (c + 1 < nch) { kp0 += 1024; kp1 += 1024; asm volatile("" : "+v"(kp0), "+v"(kp1)); r0 = *kp0; r1 = *kp1; }
            const LAS unsigned char* kb = kbuf + (c & 1) * 16384;
#pragma unroll
            for (int j = 0; j < 4; ++j) {
                float part[2];
#pragma unroll
                for (int hh = 0; hh < 2; ++hh) {
                    const int row = 16 * (2 * j + hh) + m16;
                    const bf16x8 b0 = *(const LAS bf16x8*)(kb + row * 128 + ((g ^ (row & 7)) * 16));
                    const bf16x8 b1 = *(const LAS bf16x8*)(kb + row * 128 + (((4 + g) ^ (row & 7)) * 16));
                    f32x4 cc = {0.f, 0.f, 0.f, 0.f};
                    cc = __builtin_amdgcn_mfma_f32_16x16x32_bf16(a0, b0, cc, 0, 0, 0);
                    cc = __builtin_amdgcn_mfma_f32_16x16x32_bf16(a1, b1, cc, 0, 0, 0);
                    part[hh] = (wv[0] * fmaxf(cc[0], 0.f) + wv[1] * fmaxf(cc[1], 0.f)) + (wv[2] * fmaxf(cc[2], 0.f) + wv[3] * fmaxf(cc[3], 0.f));
                }
                const bool odd = (g & 1) != 0;
                const float send = odd ? part[0] : part[1], keep = odd ? part[1] : part[0];
                const float tot = keep + __shfl_xor(send, 16);
                const int key = 128 * c + 32 * j + keyl;
                vmin = fminf(vmin, tot);
                const float s = (key <= tq) ? tot : -INFINITY;
                vmax = fmaxf(vmax, s);
                sc[4 * c + j] = s;
            }
            if (c + 1 < nch) { *(LAS u32x4t*)(kbuf + ((c + 1) & 1) * 16384 + KU_ADDR(tid)) = r0; *(LAS u32x4t*)(kbuf + ((c + 1) & 1) * 16384 + KU_ADDR(512 + tid)) = r1; }
            __syncthreads();
        }
    }
#undef KU_ADDR
#pragma unroll
    for (int o = 1; o < 32; o <<= 1) { vmin = fminf(vmin, __shfl_xor(vmin, o)); vmax = fmaxf(vmax, __shfl_xor(vmax, o)); }
    float lo = vmin - 1.0f - fabsf(vmin) * 1e-3f, hi = vmax; int chi = 0; bool done = false;
    for (int it = 0; it < 64; ++it) {
        const float mid = lo + 0.5f * (hi - lo);
        const bool act = !done && (mid > lo) && (mid < hi);
        if (!__any(act)) break;
        int cA = 0, cB = 0;
#pragma unroll
        for (int c = 0; c < 32; ++c) {
            if (c < nch) {
#pragma unroll
                for (int j = 0; j < 4; ++j) { const unsigned long long mk = __ballot(sc[4 * c + j] > mid); cA += __popc((unsigned)mk); cB += __popc((unsigned)(mk >> 32)); }
            }
        }
        const int cnt = half ? cB : cA;
        if (act) { if (cnt == TOPK) { hi = mid; chi = TOPK; done = true; } else if (cnt > TOPK) { lo = mid; } else { hi = mid; chi = cnt; } }
    }
    LAS u16* oq = ost + half * TOPK;
    int pg = 0, pe = chi;
#pragma unroll
    for (int c = 0; c < 32; ++c) {
        if (c < nch) {
#pragma unroll
            for (int j = 0; j < 4; ++j) {
                const float s = sc[4 * c + j];
                const bool gt = s > hi, eq = (s > lo) && !gt;
                const unsigned long long mg = __ballot(gt), me = __ballot(eq);
                const unsigned mgh = half ? (unsigned)(mg >> 32) : (unsigned)mg, meh = half ? (unsigned)(me >> 32) : (unsigned)me;
                const unsigned below = (1u << keyl) - 1u;
                const int rg = __popc(mgh & below), re = __popc(meh & below);
                const u16 key = (u16)(128 * c + 32 * j + keyl);
                if (gt) oq[pg + rg] = key;
                if (eq && (pe + re < TOPK)) oq[pe + re] = key;
                pg += __popc(mgh); pe += __popc(meh);
            }
        }
    }
    LDS_WAIT(); asm volatile("" ::: "memory");
    *(GAS u32x4t*)(IDX + ((size_t)b * SEQ + tA) * TOPK + 8 * lane) = *(const LAS u32x4t*)((const LAS unsigned char*)ost + 16 * lane);
    LDS_WAIT(); asm volatile("" ::: "memory");
}
constexpr int SP_WAVE_BYTES = 16896;
__device__ __forceinline__ unsigned sp_swz(unsigned row) { return ((row & 3u) << 2) | ((row >> 2) & 3u); }
__device__ __forceinline__ unsigned sp_off(unsigned row, unsigned ch) { return 256u * row + 16u * (ch ^ sp_swz(row)); }
typedef short v4i16_t __attribute__((ext_vector_type(4)));
__device__ __forceinline__ void build_lut(const float* rel_bias, Frame& F) {
    LAS float* lut = (LAS float*)(F.lds + LUT_OFF);
    for (int e = F.tid; e < 129 * 16; e += NWAVES * 64) { const int d = e >> 4, hh = e & 15; int bk = d;
        if (d >= 16) { bk = 16 + (int)(logf((float)d * (1.0f / 16.0f)) / 2.0794415416798357f * 16.0f); bk = bk < 31 ? bk : 31; }
        lut[e] = (hh < 8) ? rel_bias[bk * 8 + hh] * K_LOG2E_F : 0.f; }
}
__device__ __forceinline__ void sparse_query(bf16* ATT, const bf16* CKV, const u16* IDX, int row, Frame& F) {
    const int lane = F.lane, n = lane & 15, g = lane >> 4;
    const int b = row >> 12, t = row & (SEQ - 1);
    LAS unsigned char* wl = F.lds + RING_OFF + F.wave * SP_WAVE_BYTES;
    LAS u16* idxs = (LAS u16*)(wl + 16384);
    const LAS float* lut = (const LAS float*)(F.lds + LUT_OFF);
    { typedef unsigned u32x2t __attribute__((ext_vector_type(2)));
      *(LAS u32x2t*)(wl + 16384 + 8 * lane) = *(const GAS u32x2t*)(IDX + (size_t)row * TOPK + 4 * lane); }
    bf16x8 qf[4];
#pragma unroll
    for (int s = 0; s < 4; ++s) { bf16x8 z = {0, 0, 0, 0, 0, 0, 0, 0}; qf[s] = (n < 8) ? *(const bf16x8*)(ATT + (size_t)row * 1536 + n * 128 + 32 * s + 8 * g) : z; }
    LDS_WAIT(); asm volatile("" ::: "memory");
    const bf16* cb = CKV + (size_t)b * SEQ * 128;
    u32x4t stg[8];
#define SP_ISSUE(c) do { _Pragma("unroll") for (int i = 0; i < 8; ++i) { const unsigned rho = 4u * i + g; const unsigned key = idxs[32 * (c) + rho]; \
        stg[i] = *(const GAS u32x4t*)(cb + (size_t)key * 128 + ((unsigned)n ^ sp_swz(rho)) * 8); } } while (0)
#define SP_STORE(buf) do { _Pragma("unroll") for (int i = 0; i < 8; ++i) { const unsigned rho = 4u * i + g; *(LAS u32x4t*)((buf) + 256u * rho + 16u * n) = stg[i]; } } while (0)
    float m_run = -INFINITY, l_part = 0.f;
    f32x4 O[8];
#pragma unroll
    for (int cc = 0; cc < 8; ++cc) O[cc] = (f32x4){0.f, 0.f, 0.f, 0.f};
    SP_ISSUE(0); SP_STORE(wl);
    const unsigned rA0 = 8u * (n >> 2) + (n & 3u), rA1 = rA0 + 4u;
    const unsigned q4 = (unsigned)n >> 2, p4 = (unsigned)n & 3u;
    for (int c = 0; c < 8; ++c) {
        LAS unsigned char* cur = wl + (c & 1) * 8192; LAS unsigned char* nxt = wl + ((c + 1) & 1) * 8192;
        if (c < 7) SP_ISSUE(c + 1);
        LDS_WAIT(); asm volatile("" ::: "memory");
        f32x4 S0 = {0.f, 0.f, 0.f, 0.f}, S1 = {0.f, 0.f, 0.f, 0.f};
#pragma unroll
        for (int s = 0; s < 4; ++s) {
            const bf16x8 k0 = *(const LAS bf16x8*)(cur + sp_off(rA0, 4 * s + g)), k1 = *(const LAS bf16x8*)(cur + sp_off(rA1, 4 * s + g));
            S0 = __builtin_amdgcn_mfma_f32_16x16x32_bf16(k0, qf[s], S0, 0, 0, 0);
            S1 = __builtin_amdgcn_mfma_f32_16x16x32_bf16(k1, qf[s], S1, 0, 0, 0);
        }
        float lg[8];
#pragma unroll
        for (int i = 0; i < 8; ++i) { const int key = idxs[32 * c + 8 * g + i]; const int dist = t - key; const int dc = dist < 128 ? dist : 128;
            const float sv = (i < 4) ? S0[i & 3] : S1[i & 3];
            lg[i] = (dist < 0) ? -INFINITY : sv + lut[(dc < 0 ? 0 : dc) * 16 + n]; }
        float mx = fmaxf(fmaxf(fmaxf(lg[0], lg[1]), fmaxf(lg[2], lg[3])), fmaxf(fmaxf(lg[4], lg[5]), fmaxf(lg[6], lg[7])));
        mx = fmaxf(mx, __shfl_xor(mx, 16)); mx = fmaxf(mx, __shfl_xor(mx, 32));
        const float m_new = fmaxf(m_run, mx);
        const float alpha = __builtin_amdgcn_exp2f(m_run - m_new);
        m_run = m_new;
        float ps = 0.f; float p[8];
#pragma unroll
        for (int i = 0; i < 8; ++i) { p[i] = __builtin_amdgcn_exp2f(lg[i] - m_new); ps += p[i]; }
        l_part = l_part * alpha + ps;
        u32x4t pw; pw.x = pk2(p[0], p[1]); pw.y = pk2(p[2], p[3]); pw.z = pk2(p[4], p[5]); pw.w = pk2(p[6], p[7]);
        const bf16x8 pa = __builtin_bit_cast(bf16x8, pw);
        { const float al0 = __shfl(alpha, 4 * g), al1 = __shfl(alpha, 4 * g + 1), al2 = __shfl(alpha, 4 * g + 2), al3 = __shfl(alpha, 4 * g + 3);
#pragma unroll
          for (int cc = 0; cc < 8; ++cc) { O[cc][0] *= al0; O[cc][1] *= al1; O[cc][2] *= al2; O[cc][3] *= al3; } }
#pragma unroll
        for (int cc = 0; cc < 8; ++cc) {
            const v4i16_t lo4 = __builtin_amdgcn_ds_read_tr16_b64_v4i16((LAS v4i16_t*)(cur + sp_off(8u * g + q4, 2u * cc + (p4 >> 1)) + 8u * (p4 & 1u)));
            const v4i16_t hi4 = __builtin_amdgcn_ds_read_tr16_b64_v4i16((LAS v4i16_t*)(cur + sp_off(8u * g + 4u + q4, 2u * cc + (p4 >> 1)) + 8u * (p4 & 1u)));
            const bf16x8 vb = {lo4[0], lo4[1], lo4[2], lo4[3], hi4[0], hi4[1], hi4[2], hi4[3]};
            O[cc] = __builtin_amdgcn_mfma_f32_16x16x32_bf16(pa, vb, O[cc], 0, 0, 0);
        }
        if (c < 7) SP_STORE(nxt);
    }
#undef SP_ISSUE
#undef SP_STORE
    float lt = l_part; lt += __shfl_xor(lt, 16); lt += __shfl_xor(lt, 32);
    const float inv = 1.0f / lt;
    const float i0 = __shfl(inv, 4 * g), i1 = __shfl(inv, 4 * g + 1), i2 = __shfl(inv, 4 * g + 2), i3 = __shfl(inv, 4 * g + 3);
    if (g < 2) {
        bf16* orow = ATT + (size_t)row * 1536 + (4 * g) * 128 + n;
#pragma unroll
        for (int cc = 0; cc < 8; ++cc) {
            orow[0 * 128 + 16 * cc] = (bf16)f2bf(O[cc][0] * i0); orow[1 * 128 + 16 * cc] = (bf16)f2bf(O[cc][1] * i1);
            orow[2 * 128 + 16 * cc] = (bf16)f2bf(O[cc][2] * i2); orow[3 * 128 + 16 * cc] = (bf16)f2bf(O[cc][3] * i3);
        }
    }
    LDS_WAIT(); asm volatile("" ::: "memory");
}
__device__ __forceinline__ void final_norm_phase(float* out, const float* SSQ, const float* g, Frame& F) {
    const int gw = F.vcu * NWAVES + F.wave, NGW = F.G * NWAVES;
    f32x4 gv[4];
#pragma unroll
    for (int j = 0; j < 4; ++j) gv[j] = *((const f32x4*)g + F.lane + 64 * j);
    for (int m = gw; m < M; m += NGW) {
        const float rs = pg8::row_rstd(SSQ, m);
        GAS f32x4* xr = (GAS f32x4*)(out + (size_t)m * D) + F.lane;
#pragma unroll
        for (int j = 0; j < 4; ++j) { const f32x4 v = xr[64 * j]; xr[64 * j] = v * rs * gv[j]; }
    }
}
__global__ void __launch_bounds__(NWAVES * 64, 2) trunk_fwd(Params P) {
    extern __shared__ __attribute__((aligned(16))) unsigned char lds_raw[];
    Frame F;
    F.lds = (LAS unsigned char*)lds_raw;
    F.tid = threadIdx.x; F.lane = F.tid & 63; F.wave = __builtin_amdgcn_readfirstlane(F.tid >> 6);
    F.G = gridDim.x; { const int bx = blockIdx.x; F.vcu = (F.G % 8 == 0) ? (bx % 8) * (F.G / 8) + bx / 8 : bx; }
    volatile LAS unsigned* MISC = (volatile LAS unsigned*)(F.lds + MISC_OFF);
    for (int u = F.tid; u < 64; u += NWAVES * 64) MISC[u] = 0u;
    __syncthreads();
    typedef const __attribute__((address_space(4))) Params* kparams_t;
#define KP() ({ kparams_t kp_ = (kparams_t)__builtin_amdgcn_kernarg_segment_ptr(); asm volatile("" : "+s"(kp_)); kp_; })
    const int lo = P.ph_lo, hi = P.ph_hi;
#if MK_PER_PHASE
#define GRID_BAR() do { } while (0)
#else
    XcdBarrier bar = xcd_barrier_post((unsigned*)((gu32*)(P.ws + WS_CTL) + CW_BAR), MISC + 8);
#define GRID_BAR() xcd_barrier(bar)
#endif
#define IN(k) (lo <= (k) && (k) < hi)
#define MKF() Frame Fp; { int t_ = threadIdx.x, g_ = gridDim.x, b_ = blockIdx.x; asm volatile("" : "+v"(t_), "+s"(g_), "+s"(b_)); Fp.lds = F.lds; Fp.tid = t_; Fp.lane = t_ & 63; Fp.wave = __builtin_amdgcn_readfirstlane(t_ >> 6); \
        Fp.G = g_; Fp.bx = b_; Fp.vcu = (g_ % 8 == 0) ? (b_ % 8) * (g_ / 8) + b_ / 8 : b_; }
#define SEAM(k) do { if (IN(k) && IN((k) + 1)) GRID_BAR(); } while (0)

    if (IN(0)) { kparams_t kp = KP(); MKF(); prologue_phase(kp, Fp); VM_WAIT(); __syncthreads(); }
    SEAM(0);
    for (int l = 0; l < DEPTH; ++l) {
        const int pb = 1 + 8 * l;
        if (IN(pb + 0)) { kparams_t kp = KP(); MKF(); unsigned char* ws = kp->ws; const bf16* Wl = (const bf16*)(ws + WS_W) + (size_t)l * W_LAYER;
            pg8::Gemm g{(const bf16*)(ws + WS_HB), Wl + W_GU1, M, NGU, D}; pg8::StaticOrder S; S.init(M, NGU, Fp.G, Fp.bx);
            pg8::EpiSwiGLU E{(bf16*)(ws + WS_BIG), DFF, (const float*)(ws + WS_SSQ)};
            pg8::gemm_phase<pg8::EpiSwiGLU, pg8::StaticOrder, true, true>(Fp.lds + RING_OFF, g, S, E); }
        SEAM(pb + 0);
        if (IN(pb + 1)) { kparams_t kp = KP(); MKF(); unsigned char* ws = kp->ws; const bf16* Wl = (const bf16*)(ws + WS_W) + (size_t)l * W_LAYER; float* out = kp->out;
            pg8::Gemm g{(const bf16*)(ws + WS_BIG), Wl + W_D1, M, D, DFF}; pg8::StaticOrder S; S.init(M, D, Fp.G, Fp.bx);
            pg8::EpiRes E{(l == 0) ? kp->in[0] : (const float*)out, out, (bf16*)(ws + WS_HB), (float*)(ws + WS_SSQ), 0.5f};
            pg8::gemm_phase<pg8::EpiRes, pg8::StaticOrder, true, true>(Fp.lds + RING_OFF, g, S, E); }
        SEAM(pb + 1);
        if (IN(pb + 2)) { kparams_t kp = KP(); MKF(); unsigned char* ws = kp->ws; const bf16* Wl = (const bf16*)(ws + WS_W) + (size_t)l * W_LAYER;
            pg8::Gemm g{(const bf16*)(ws + WS_HB), Wl + W_IN, M, NIN, D}; pg8::StaticOrder S; S.init(M, NIN, Fp.G, Fp.bx);
            pg8::EpiProj E{(bf16*)(ws + WS_ATT), (bf16*)(ws + WS_QI), (bf16*)(ws + WS_FK), (bf16*)(ws + WS_FV), (bf16*)(ws + WS_KI), (float*)(ws + WS_CR), (float*)(ws + WS_WI), (float*)(ws + WS_FL), (const float*)(ws + WS_SSQ)};
            pg8::gemm_phase<pg8::EpiProj, pg8::StaticOrder, true, true>(Fp.lds + RING_OFF, g, S, E); }
        SEAM(pb + 2);
        if (IN(pb + 3)) {
            { kparams_t kp = KP(); MKF(); unsigned char* ws = kp->ws;
              for (int bh = Fp.bx; bh < 64; bh += Fp.G) scan_unit((const float*)(ws + WS_FL), kp->in[7] + l * 8, (float*)(ws + WS_CUM), bh, Fp);
              ckv_rows((const float*)(ws + WS_CR), kp->in[8] + l * 128, (bf16*)(ws + WS_CKV), Fp); }
            __syncthreads();
            { kparams_t kp = KP(); MKF(); unsigned char* ws = kp->ws;
              for (int v = Fp.vcu; v < 256; v += Fp.G)
                  for (int b = 0; b < NB; ++b) topk_unit((const bf16*)(ws + WS_QI), (const bf16*)(ws + WS_KI), (const float*)(ws + WS_WI), (u16*)(ws + WS_IDX), b, (b & 1) ? 255 - v : v, Fp); }
            VM_WAIT(); __syncthreads();
        }
        SEAM(pb + 3);
        if (IN(pb + 4)) {
            { kparams_t kp = KP(); MKF(); unsigned char* ws = kp->ws; bf16* ATT = (bf16*)(ws + WS_ATT);
              const attn_body::AttnTensors AT{(const attn_body::bf16*)(ATT + 1024), (const attn_body::bf16*)(ws + WS_FK), (const attn_body::bf16*)(ws + WS_FV), (attn_body::bf16*)(ATT + 1024), (const float*)(ws + WS_CUM)};
              attn_body::attn_phase<8>((char*)lds_raw + RING_OFF, AT, Fp.vcu, Fp.G); }
            VM_WAIT(); __syncthreads();
            { kparams_t kp = KP(); MKF(); build_lut(kp->in[16], Fp); }
            __syncthreads();
            { kparams_t kp = KP(); MKF(); unsigned char* ws = kp->ws;
              for (int q = Fp.vcu * NWAVES + Fp.wave; q < M; q += Fp.G * NWAVES) sparse_query((bf16*)(ws + WS_ATT), (const bf16*)(ws + WS_CKV), (const u16*)(ws + WS_IDX), q, Fp); }
            VM_WAIT(); __syncthreads();
        }
        SEAM(pb + 4);
        if (IN(pb + 5)) { kparams_t kp = KP(); MKF(); unsigned char* ws = kp->ws; const bf16* Wl = (const bf16*)(ws + WS_W) + (size_t)l * W_LAYER; float* out = kp->out;
            pg8::Gemm g{(const bf16*)(ws + WS_ATT), Wl + W_OUT, M, D, KOUT}; pg8::StaticOrder S; S.init(M, D, Fp.G, Fp.bx);
            pg8::EpiRes E{out, out, (bf16*)(ws + WS_HB), (float*)(ws + WS_SSQ), 1.0f};
            pg8::gemm_phase<pg8::EpiRes, pg8::StaticOrder, true, true>(Fp.lds + RING_OFF, g, S, E); }
        SEAM(pb + 5);
        if (IN(pb + 6)) { kparams_t kp = KP(); MKF(); unsigned char* ws = kp->ws; const bf16* Wl = (const bf16*)(ws + WS_W) + (size_t)l * W_LAYER;
            pg8::Gemm g{(const bf16*)(ws + WS_HB), Wl + W_GU2, M, NGU, D}; pg8::StaticOrder S; S.init(M, NGU, Fp.G, Fp.bx);
            pg8::EpiSwiGLU E{(bf16*)(ws + WS_BIG), DFF, (const float*)(ws + WS_SSQ)};
            pg8::gemm_phase<pg8::EpiSwiGLU, pg8::StaticOrder, true, true>(Fp.lds + RING_OFF, g, S, E); }
        SEAM(pb + 6);
        if (IN(pb + 7)) { kparams_t kp = KP(); MKF(); unsigned char* ws = kp->ws; const bf16* Wl = (const bf16*)(ws + WS_W) + (size_t)l * W_LAYER; float* out = kp->out;
            pg8::Gemm g{(const bf16*)(ws + WS_BIG), Wl + W_D2, M, D, DFF}; pg8::StaticOrder S; S.init(M, D, Fp.G, Fp.bx);
            pg8::EpiRes E{out, out, (bf16*)(ws + WS_HB), (float*)(ws + WS_SSQ), 0.5f};
            pg8::gemm_phase<pg8::EpiRes, pg8::StaticOrder, true, true>(Fp.lds + RING_OFF, g, S, E); }
        SEAM(pb + 7);
    }
    if (IN(NPHASE - 1)) { kparams_t kp = KP(); MKF(); final_norm_phase(kp->out, (const float*)(kp->ws + WS_SSQ), kp->in[17], Fp); }
#undef IN
#undef MKF
#undef SEAM
#undef GRID_BAR
}

extern "C" void kernel_launch(void* const* d_in, const int* in_sizes, int n_in, void* d_out, int out_size, void* d_ws, size_t ws_size, hipStream_t stream) {
    static int grid = 0;
    if (grid == 0) {
        if (n_in != 18 || in_sizes[0] != M * D || out_size != M * D || ws_size < WS_END) { fprintf(stderr, "kernel_launch: unexpected shapes (n_in %d, in0 %d, out %d, ws %zu < %zu); nothing launched\n", n_in, n_in > 0 ? in_sizes[0] : -1, out_size, ws_size, (size_t)WS_END); grid = -1; return; }
        int dev = 0, cus = 0, per_cu = 0;
        if (hipGetDevice(&dev) != hipSuccess || hipDeviceGetAttribute(&cus, hipDeviceAttributeMultiprocessorCount, dev) != hipSuccess) { grid = -1; return; }
        if (hipFuncSetAttribute((const void*)trunk_fwd, hipFuncAttributeMaxDynamicSharedMemorySize, LDS_BYTES) != hipSuccess) { fprintf(stderr, "kernel_launch: hipFuncSetAttribute failed\n"); grid = -1; return; }
        if (hipOccupancyMaxActiveBlocksPerMultiprocessor(&per_cu, (const void*)trunk_fwd, NWAVES * 64, LDS_BYTES) != hipSuccess || per_cu < 1) { fprintf(stderr, "kernel_launch: occupancy query says %d\n", per_cu); }
        (void)hipGetLastError();
        grid = cus;
    }
    if (grid < 0) return;
    if (hipMemsetAsync((char*)d_ws + WS_CTL, 0, CTL_ZERO_BYTES, stream) != hipSuccess) return;
    Params p{};
    for (int i = 0; i < 18; ++i) p.in[i] = (const float*)d_in[i];
    p.out = (float*)d_out; p.ws = (unsigned char*)d_ws;
#if MK_PER_PHASE
    for (int ph = 0; ph < NPHASE; ++ph) { p.ph_lo = ph; p.ph_hi = ph + 1; hipLaunchKernelGGL(trunk_fwd, dim3(grid), dim3(NWAVES * 64), LDS_BYTES, stream, p); }
#else
    p.ph_lo = 0; p.ph_hi = NPHASE;
    hipLaunchKernelGGL(trunk_fwd, dim3(grid), dim3(NWAVES * 64), LDS_BYTES, stream, p);
#endif
}
```

```cpp
#include <hip/hip_runtime.h>
#include <hip/hip_bf16.h>
#include <cstdio>
#include <cstdint>
#include <cmath>
namespace pg8 {
#define PG8_LAS __attribute__((address_space(3)))
typedef unsigned short bf16_t;
typedef short bf16x8 __attribute__((ext_vector_type(8)));
typedef float f32x4 __attribute__((ext_vector_type(4)));
typedef unsigned u32x4 __attribute__((ext_vector_type(4)));
constexpr int BM = 256, BK = 64, HALF = 128, HTB = HALF * BK * 2  , STAGE_BYTES = 8 * HTB, NXCD = 8, WGM = 8;

__host__ __device__ __forceinline__ int lds_byte(int r, int c) { const int st = (r >> 4) * 2 + (c >> 5), rr = r & 15, cc = c & 31, ob = rr * 64 + cc * 2; return st * 1024 + (ob ^ (((ob >> 9) & 1) << 5)); }
__host__ __device__ __forceinline__ void stage_rc(int b, int& R, int& C) { const int st = b / 1024, sb = b % 1024, swz = sb ^ (((sb >> 9) & 1) << 5); R = (st >> 1) * 16 + swz / 64; C = (st & 1) * 32 + (swz % 64) / 2; }
__host__ __device__ __forceinline__ int perm32(int rho) { const int n = rho >> 4, i = rho & 15; return 8 * (i >> 2) + 4 * n + (i & 3); }

struct Unit { int pm, pn; };
struct Gemm { const bf16_t* A; const bf16_t* Bt; int M, N, K, lda; };

struct StaticOrder {
    int nM, nN, nwg, G, c;
    __host__ __device__ void init(int M, int N, int G_, int c_) { nM = M / BM; nN = N / BM; nwg = nM * nN; G = G_; c = c_; }
    __host__ __device__ bool next(int i, Unit& u) const {
        const long L = (long)i * G + c; if (L >= nwg) return false;
        int wgid = (int)L; { const int q = nwg / NXCD, r = nwg % NXCD, xcd = wgid % NXCD, off = wgid / NXCD; wgid = (xcd < r ? xcd * (q + 1) : r * (q + 1) + (xcd - r) * q) + off; }
        const int nig = WGM * nN, gid = wgid / nig, fm = gid * WGM, gsz = (nM - fm) < WGM ? (nM - fm) : WGM;
        u.pm = fm + ((wgid % nig) % gsz); u.pn = (wgid % nig) / gsz; return true;
    }
    __device__ __forceinline__ void a_ready(const Unit&) const {}
    __device__ __forceinline__ void done(const Unit&) const {}
};

typedef float f32x2c __attribute__((ext_vector_type(2))); typedef __bf16 bf16x2c __attribute__((ext_vector_type(2)));
__device__ __forceinline__ unsigned cvt_pk_bf16(float lo, float hi) { const f32x2c v = {lo, hi}; return __builtin_bit_cast(unsigned, __builtin_convertvector(v, bf16x2c)); }
typedef float f32x2 __attribute__((ext_vector_type(2)));
typedef unsigned u32x2 __attribute__((ext_vector_type(2)));
typedef int i32x8 __attribute__((ext_vector_type(8)));
constexpr float F8_HID = 16.0f;
constexpr float F8_HS = 24.0f;
__device__ __forceinline__ unsigned f8pk4(float a, float b, float c, float d, float s) {
    const float MG = 12582912.0f;
    const float t0 = fminf(fmaxf(fmaf(a, s, MG), MG - 127.f), MG + 127.f), t1 = fminf(fmaxf(fmaf(b, s, MG), MG - 127.f), MG + 127.f);
    const float t2 = fminf(fmaxf(fmaf(c, s, MG), MG - 127.f), MG + 127.f), t3 = fminf(fmaxf(fmaf(d, s, MG), MG - 127.f), MG + 127.f);
    return __builtin_amdgcn_perm(__float_as_uint(t1), __float_as_uint(t0), 0x0c0c0400u) | __builtin_amdgcn_perm(__float_as_uint(t3), __float_as_uint(t2), 0x04000c0cu);
}
typedef int i32x4 __attribute__((ext_vector_type(4)));
constexpr float RMS_EPS = 1e-6f;
constexpr float K_LOG2E = 1.4426950408889634f;
constexpr float K_C2 = 0.125f * 1.4426950408889634f;
__device__ __forceinline__ float row_rstd(const float* ssq, int row) {
    const f32x4* p = (const f32x4*)(ssq + (size_t)row * 16);
    const f32x4 a = p[0], b = p[1], c = p[2], d = p[3];
    const float s = (((a[0] + a[1]) + (a[2] + a[3])) + ((b[0] + b[1]) + (b[2] + b[3]))) + (((c[0] + c[1]) + (c[2] + c[3])) + ((d[0] + d[1]) + (d[2] + d[3])));
    return 1.0f / sqrtf(s * (1.0f / 1024.0f) + RMS_EPS);
}
__device__ __forceinline__ const PG8_LAS float* wave_rstd_table(PG8_LAS unsigned char* tab, const float* ssq, const Unit& u, int wr, int wc, int lane) {
    PG8_LAS float* t = (PG8_LAS float*)(tab + (wr * 4 + wc) * 1024);
    if (__builtin_amdgcn_readfirstlane(__float_as_int(t[128])) != u.pm) {
#pragma unroll
        for (int k = 0; k < 2; ++k) { const int slot = lane + 64 * k; const int row = u.pm * BM + (slot >> 6) * HALF + wr * 64 + (slot & 63); t[slot] = row_rstd(ssq, row); }
        if (lane == 0) t[128] = __int_as_float(u.pm);
        asm volatile("s_waitcnt lgkmcnt(0)" ::: "memory");
    }
    return t;
}
__device__ __forceinline__ float mul_s(float a, float b) { float r; asm("v_mul_f32_e32 %0, %1, %2" : "=v"(r) : "v"(a), "v"(b)); return r; }
struct EpiSwiGLU {
    static constexpr bool PERM = true, AFTER_DRAIN = false;
    unsigned char* H; int ldh; const float* ssq; PG8_LAS unsigned char* tab; const float* wsc;
    __device__ __forceinline__ void operator()(const f32x4 (&acc)[2][2][4][2], const Unit& u, int wr, int wc, int fr, int fq) const {
        const int row0 = u.pm * BM + wr * 64 + fr, col0 = u.pn * HALF + wc * 32 + 8 * fq;
        const float* wq = wsc + u.pn * BM + wc * 32 + 8 * fq;
        const f32x4 gs0 = *(const f32x4*)wq, gs1 = *(const f32x4*)(wq + 4), us0 = *(const f32x4*)(wq + HALF), us1 = *(const f32x4*)(wq + HALF + 4);
#define PG8_MUL(x, y) mul_s((x), (y))
        float ng[8], w8[8];
#pragma unroll
        for (int e = 0; e < 4; ++e) { ng[e] = PG8_MUL(gs0[e], -K_LOG2E); ng[4 + e] = PG8_MUL(gs1[e], -K_LOG2E); w8[e] = PG8_MUL(PG8_MUL(gs0[e], us0[e]), F8_HID); w8[4 + e] = PG8_MUL(PG8_MUL(gs1[e], us1[e]), F8_HID); }
        const PG8_LAS float* rt = wave_rstd_table(tab, ssq, u, wr, wc, fr + 16 * fq);
#pragma unroll
        for (int ai = 0; ai < 2; ++ai)
#pragma unroll
            for (int m = 0; m < 4; ++m) {
                const int row = row0 + ai * HALF + m * 16; const float rs = rt[64 * ai + 16 * m + fr] * (1.0f / F8_HS); const float rs2 = PG8_MUL(rs, rs);
                float h[8];
#pragma unroll
                for (int n = 0; n < 2; ++n)
#pragma unroll
                    for (int e = 0; e < 4; ++e) { const float a = acc[ai][0][m][n][e], b = acc[ai][1][m][n][e];
                        const float r = __builtin_amdgcn_rcpf(1.0f + __builtin_amdgcn_exp2f(PG8_MUL(PG8_MUL(a, ng[4 * n + e]), rs)));
                        h[4 * n + e] = PG8_MUL(PG8_MUL(a, b), w8[4 * n + e]) * r; }
                u32x2 w; w.x = f8pk4(h[0], h[1], h[2], h[3], rs2); w.y = f8pk4(h[4], h[5], h[6], h[7], rs2);
                *(u32x2*)(H + (size_t)row * ldh + col0) = w;
                asm volatile("" ::: "memory");
            }
#undef PG8_MUL
    }
};
template <long F8D = 0, bool CS = false> struct EpiRes {
    static constexpr bool PERM = true, AFTER_DRAIN = false;
    bf16_t* hb; float* ssq; float scale; const float* wsc;
    __device__ __forceinline__ void operator()(const f32x4 (&acc)[2][2][4][2], const Unit& u, int wr, int wc, int fr, int fq) const {
        const int col0 = u.pn * BM + wc * 32 + 8 * fq;
        f32x4 cs[2][2];
#pragma unroll
        for (int bj = 0; bj < 2; ++bj)
#pragma unroll
            for (int n = 0; n < 2; ++n) { if constexpr (CS) cs[bj][n] = *(const f32x4*)(wsc + col0 + bj * HALF + 4 * n) * scale; else cs[bj][n] = (f32x4){scale, scale, scale, scale}; }
#pragma unroll
        for (int ai = 0; ai < 2; ++ai)
#pragma unroll
            for (int m = 0; m < 4; ++m) {
                const int row = u.pm * BM + ai * HALF + wr * 64 + m * 16 + fr; const size_t off = (size_t)row * 1024 + col0;
                float ss = 0.f;
#pragma unroll
                for (int bj = 0; bj < 2; ++bj) { const u32x4 b = *(const u32x4*)(hb + off + bj * HALF);
                    const f32x4 b0 = {__uint_as_float(b.x << 16), __uint_as_float(b.x & 0xffff0000u), __uint_as_float(b.y << 16), __uint_as_float(b.y & 0xffff0000u)};
                    const f32x4 b1 = {__uint_as_float(b.z << 16), __uint_as_float(b.z & 0xffff0000u), __uint_as_float(b.w << 16), __uint_as_float(b.w & 0xffff0000u)};
                    const f32x4 o0 = b0 + acc[ai][bj][m][0] * cs[bj][0], o1 = b1 + acc[ai][bj][m][1] * cs[bj][1];
                    u32x4 w; w.x = cvt_pk_bf16(o0[0], o0[1]); w.y = cvt_pk_bf16(o0[2], o0[3]); w.z = cvt_pk_bf16(o1[0], o1[1]); w.w = cvt_pk_bf16(o1[2], o1[3]);
                    *(u32x4*)(hb + off + bj * HALF) = w;
                    if constexpr (F8D != 0) { unsigned char* hb8 = (unsigned char*)hb + F8D; u32x2 q; q.x = f8pk4(o0[0], o0[1], o0[2], o0[3], F8_HS); q.y = f8pk4(o1[0], o1[1], o1[2], o1[3], F8_HS); *(u32x2*)(hb8 + off + bj * HALF) = q; }
                    ss += ((o0[0] * o0[0] + o0[1] * o0[1]) + (o0[2] * o0[2] + o0[3] * o0[3])) + ((o1[0] * o1[0] + o1[1] * o1[1]) + (o1[2] * o1[2] + o1[3] * o1[3])); }
                ss += __shfl_xor(ss, 16); ss += __shfl_xor(ss, 32);
                if (fq == 0) ssq[(size_t)row * 16 + u.pn * 4 + wc] = ss;
                asm volatile("" ::: "memory");
            }
    }
};
struct EpiProj {
    static constexpr bool PERM = true, AFTER_DRAIN = false;
    bf16_t *ATT, *QI, *FK, *FV, *KI; float *CR, *WI, *FL; const float* ssq; PG8_LAS unsigned char* tab; const float* wsc; unsigned* nrm;
    __device__ __forceinline__ void operator()(const f32x4 (&acc)[2][2][4][2], const Unit& u, int wr, int wc, int fr, int fq) const {
        const int row0 = u.pm * BM + wr * 64 + fr, pn = u.pn, cl = wc * 32 + 8 * fq;
        const float* wq = wsc + pn * BM + cl;
        const f32x4 cs[2][2] = {{*(const f32x4*)wq, *(const f32x4*)(wq + 4)}, {*(const f32x4*)(wq + HALF), *(const f32x4*)(wq + HALF + 4)}};
        const PG8_LAS float* rt = wave_rstd_table(tab, ssq, u, wr, wc, fr + 16 * fq);
        if (pn < 10) {
            bf16_t* base; int ld, colt; float sc;
            if (pn < 2) { base = ATT; ld = 1536; colt = 512 + pn * 256; sc = K_C2; }
            else if (pn < 4) { base = QI; ld = 512; colt = (pn - 2) * 256; sc = 0.125f; }
            else if (pn < 6) { base = ATT; ld = 1536; colt = (pn - 4) * 256; sc = K_C2; }
            else if (pn < 8) { base = FK; ld = 512; colt = (pn - 6) * 256; sc = 1.0f; }
            else { base = FV; ld = 512; colt = (pn - 8) * 256; sc = 1.0f; }
            const bool fox_qk = pn >= 4 && pn < 8; float hmx[2] = {0.f, 0.f};
#pragma unroll
            for (int ai = 0; ai < 2; ++ai)
#pragma unroll
                for (int m = 0; m < 4; ++m) {
                    const int row = row0 + ai * HALF + m * 16; const float rs = rt[64 * ai + 16 * m + fr] * (sc * (1.0f / F8_HS)); bf16_t* rowp = base + (size_t)row * ld + colt + cl;
#pragma unroll
                    for (int bj = 0; bj < 2; ++bj) { const f32x4 v0 = acc[ai][bj][m][0] * (cs[bj][0] * rs), v1 = acc[ai][bj][m][1] * (cs[bj][1] * rs);
                        u32x4 w; w.x = cvt_pk_bf16(v0[0], v0[1]); w.y = cvt_pk_bf16(v0[2], v0[3]); w.z = cvt_pk_bf16(v1[0], v1[1]); w.w = cvt_pk_bf16(v1[2], v1[3]);
                        *(u32x4*)(rowp + bj * HALF) = w;
                        if (fox_qk) { float hs = ((v0[0] * v0[0] + v0[1] * v0[1]) + (v0[2] * v0[2] + v0[3] * v0[3])) + ((v1[0] * v1[0] + v1[1] * v1[1]) + (v1[2] * v1[2] + v1[3] * v1[3]));
                            hs += __shfl_xor(hs, 16); hs += __shfl_xor(hs, 32); hmx[bj] = fmaxf(hmx[bj], hs); } }
                    asm volatile("" ::: "memory");
                }
            if (fox_qk) {
#pragma unroll
                for (int bj = 0; bj < 2; ++bj) { float m_ = hmx[bj];
#pragma unroll
                    for (int o = 1; o < 16; o <<= 1) m_ = fmaxf(m_, __shfl_xor(m_, o));
                    if (fr == 0 && fq == 0) atomicMax(nrm + (((u.pm >> 4) * 8 + (pn & 1) * 4 + bj * 2 + (wc >> 1)) * 2 + (pn >= 6 ? 1 : 0)), __float_as_uint(m_)); }
            }
        } else {
#pragma unroll
            for (int ai = 0; ai < 2; ++ai)
#pragma unroll
                for (int m = 0; m < 4; ++m) {
                    const int row = row0 + ai * HALF + m * 16; const float rs = rt[64 * ai + 16 * m + fr] * (1.0f / F8_HS);
                    *(f32x4*)(CR + (size_t)row * 128 + cl) = acc[ai][0][m][0] * (cs[0][0] * rs); *(f32x4*)(CR + (size_t)row * 128 + cl + 4) = acc[ai][0][m][1] * (cs[0][1] * rs);
                    const f32x4 v0 = acc[ai][1][m][0] * (cs[1][0] * rs), v1 = acc[ai][1][m][1] * (cs[1][1] * rs);
                    if (wc < 2) { u32x4 w; w.x = cvt_pk_bf16(v0[0], v0[1]); w.y = cvt_pk_bf16(v0[2], v0[3]); w.z = cvt_pk_bf16(v1[0], v1[1]); w.w = cvt_pk_bf16(v1[2], v1[3]);
                        *(u32x4*)(KI + (size_t)row * 64 + cl) = w; }
                    else if (wc == 2) {
                        if (fq == 0) { const float s8 = 0.35355339059327373f; *(f32x4*)(WI + (size_t)row * 8) = v0 * s8; *(f32x4*)(WI + (size_t)row * 8 + 4) = v1 * s8; }
                        else if (fq == 1) { *(f32x4*)(FL + (size_t)row * 8) = v0; *(f32x4*)(FL + (size_t)row * 8 + 4) = v1; }
                    }
                    asm volatile("" ::: "memory");
                }
        }
    }
};

template <class Epi, class Sched, bool ALIGN_EPI = false, bool SP2 = false, bool F8 = false>
__device__ __forceinline__ void gemm_phase(PG8_LAS unsigned char* lds, const Gemm g, const Sched& S, const Epi& E) {
    int tid_ = threadIdx.x; asm volatile("" : "+v"(tid_));
    const int tid = tid_, wid = __builtin_amdgcn_readfirstlane(tid >> 6), lane = tid & 63, wr = wid >> 2, wc = wid & 3, fr = lane & 15, fq = lane >> 4;
    int K_ = g.K; asm volatile("" : "+s"(K_));
    const int K = K_, nt = K / BK, lda = g.lda;
    unsigned voffA[2], voffB[2];
#pragma unroll
    for (int i = 0; i < 2; ++i) { int R, C; stage_rc(tid * 16 + i * 8192, R, C); const int Rb = Epi::PERM ? ((R & ~31) + perm32(R & 31)) : R;
        voffA[i] = (unsigned)(R * lda + C) * 2u; voffB[i] = (unsigned)(Rb * K + C) * 2u; }
    const size_t kstep = (size_t)(BK * 2);
    const size_t hstep = (size_t)HALF * K * 2;
    const size_t tstep = 2 * hstep;
    const size_t hstepA = (size_t)HALF * lda * 2, tstepA = 2 * hstepA;
    const unsigned ldsw = (unsigned)wid * 1024u;
    const int aoff = lds_byte(wr * 64 + fr, fq * 8), boff = lds_byte(wc * 32 + fr, fq * 8);
#define PG8_SA(b, h) (((b) * 2 + (h)) * HTB)
#define PG8_SB(b, h) ((4 + (b) * 2 + (h)) * HTB)
#define PG8_STAGE(bufoff, gbase, voff) do { _Pragma("unroll") for (int _i = 0; _i < 2; ++_i) \
        __builtin_amdgcn_global_load_lds((const unsigned*)((const char*)(gbase) + (voff)[_i]), (PG8_LAS unsigned*)(lds + (bufoff) + ldsw + _i * 8192), 16, 0, 0); } while (0)
#define PG8_LDA(dst, b, h) do { _Pragma("unroll") for (int m = 0; m < 4; ++m) _Pragma("unroll") for (int k = 0; k < 2; ++k) dst[m][k] = *(const PG8_LAS bf16x8*)(lds + PG8_SA(b, h) + aoff + m * 2048 + k * 1024); } while (0)
#define PG8_LDB(dst, b, h) do { _Pragma("unroll") for (int n = 0; n < 2; ++n) _Pragma("unroll") for (int k = 0; k < 2; ++k) dst[n][k] = *(const PG8_LAS bf16x8*)(lds + PG8_SB(b, h) + boff + n * 2048 + k * 1024); } while (0)
#define PG8_MMA(ai, bj, At, Bt) do { __builtin_amdgcn_s_setprio(1); _Pragma("unroll") for (int m = 0; m < 4; ++m) _Pragma("unroll") for (int n = 0; n < 2; ++n) _Pragma("unroll") for (int k = 0; k < 2; ++k) { \
        if constexpr (F8) acci[ai][bj][m][n] = __builtin_amdgcn_mfma_i32_16x16x64_i8(__builtin_bit_cast(i32x4, Bt[n][k]), __builtin_bit_cast(i32x4, At[m][k]), acci[ai][bj][m][n], 0, 0, 0); \
        else acc[ai][bj][m][n] = __builtin_amdgcn_mfma_f32_16x16x32_bf16(Bt[n][k], At[m][k], acc[ai][bj][m][n], 0, 0, 0); } \
        __builtin_amdgcn_s_setprio(0); } while (0)
#define PG8_WAIT_V(n) asm volatile("s_waitcnt vmcnt(" #n ")" ::: "memory")
#define PG8_WAIT_L(n) asm volatile("s_waitcnt lgkmcnt(" #n ")" ::: "memory")
#define PG8_BAR __builtin_amdgcn_s_barrier()
#define PG8_SCHED __builtin_amdgcn_sched_barrier(0)
    Unit cur, nxt; int ui = 0;
    if (!S.next(0, cur)) return;
    f32x4 acc[2][2][4][2]; i32x4 acci[2][2][4][2];
#pragma unroll
    for (int a = 0; a < 2; ++a)
#pragma unroll
        for (int b = 0; b < 2; ++b)
#pragma unroll
            for (int m = 0; m < 4; ++m)
#pragma unroll
                for (int n = 0; n < 2; ++n) { if constexpr (F8) acci[a][b][m][n] = (i32x4){0, 0, 0, 0}; else acc[a][b][m][n] = (f32x4){0.f, 0.f, 0.f, 0.f}; }
    bf16x8 At[4][2], B0[2][2], B1[2][2];
    const char* cA = (const char*)g.A + (size_t)cur.pm * tstepA; const char* cB = (const char*)g.Bt + (size_t)cur.pn * tstep;
    S.a_ready(cur);
    if constexpr (SP2) {
        PG8_STAGE(PG8_SB(0, 0), cB, voffB); PG8_STAGE(PG8_SB(0, 1), cB + hstep, voffB); PG8_STAGE(PG8_SA(0, 0), cA, voffA); PG8_STAGE(PG8_SA(0, 1), cA + hstepA, voffA);
        if (wr == 1) PG8_BAR;
        PG8_WAIT_V(2); PG8_BAR;
        PG8_STAGE(PG8_SB(1, 0), cB + kstep, voffB); PG8_STAGE(PG8_SA(1, 0), cA + kstep, voffA); PG8_STAGE(PG8_SB(1, 1), cB + hstep + kstep, voffB);
        PG8_WAIT_V(6); PG8_BAR;
    } else {
        PG8_STAGE(PG8_SB(0, 0), cB, voffB); PG8_STAGE(PG8_SA(0, 0), cA, voffA); PG8_STAGE(PG8_SB(0, 1), cB + hstep, voffB); PG8_STAGE(PG8_SA(0, 1), cA + hstepA, voffA);
        if (wr == 1) PG8_BAR;
        PG8_WAIT_V(4); PG8_BAR;
        PG8_STAGE(PG8_SB(1, 0), cB + kstep, voffB); PG8_STAGE(PG8_SA(1, 0), cA + kstep, voffA); PG8_STAGE(PG8_SB(1, 1), cB + hstep + kstep, voffB);
        PG8_WAIT_V(6); PG8_BAR;
    }
    for (;;) {
        const bool has_next = S.next(ui + 1, nxt);
        const char* nA = has_next ? (const char*)g.A + (size_t)nxt.pm * tstepA : cA; const char* nB = has_next ? (const char*)g.Bt + (size_t)nxt.pn * tstep : cB;
#pragma unroll 1
        for (int t = 0; t < nt; t += 2) {
            const bool last = (t == nt - 2);
            const char* a1 = cA + (size_t)(t + 1) * kstep;
            const char* a2 = last ? nA : cA + (size_t)(t + 2) * kstep; const char* b2 = last ? nB : cB + (size_t)(t + 2) * kstep;
            const char* a3 = a2 + kstep; const char* b3 = b2 + kstep;
            if (last && has_next) S.a_ready(nxt);
            if constexpr (SP2) {
            PG8_LDB(B0, 0, 0); PG8_LDB(B1, 0, 1); PG8_SCHED; PG8_LDA(At, 0, 0); PG8_STAGE(PG8_SA(1, 1), a1 + hstepA, voffA);
            PG8_WAIT_V(8); PG8_WAIT_L(0); PG8_BAR; PG8_MMA(0, 0, At, B0); PG8_MMA(0, 1, At, B1); PG8_BAR; PG8_SCHED;
            PG8_LDA(At, 0, 1); PG8_STAGE(PG8_SB(0, 0), b2, voffB); PG8_STAGE(PG8_SB(0, 1), b2 + hstep, voffB); PG8_STAGE(PG8_SA(0, 0), a2, voffA);
            PG8_WAIT_V(8); PG8_WAIT_L(0); PG8_BAR; PG8_MMA(1, 0, At, B0); PG8_MMA(1, 1, At, B1); PG8_BAR; PG8_SCHED;
            PG8_LDB(B0, 1, 0); PG8_LDB(B1, 1, 1); PG8_SCHED; PG8_LDA(At, 1, 0); PG8_STAGE(PG8_SA(0, 1), a2 + hstepA, voffA);
            PG8_WAIT_V(8); PG8_WAIT_L(0); PG8_BAR; PG8_MMA(0, 0, At, B0); PG8_MMA(0, 1, At, B1); PG8_BAR; PG8_SCHED;
            PG8_LDA(At, 1, 1); PG8_STAGE(PG8_SB(1, 0), b3, voffB); PG8_STAGE(PG8_SB(1, 1), b3 + hstep, voffB); PG8_STAGE(PG8_SA(1, 0), a3, voffA);
            PG8_WAIT_V(8); PG8_WAIT_L(0); PG8_BAR; PG8_MMA(1, 0, At, B0); PG8_MMA(1, 1, At, B1); PG8_BAR; PG8_SCHED;
            } else {
            PG8_LDB(B0, 0, 0); PG8_SCHED; PG8_LDA(At, 0, 0); PG8_STAGE(PG8_SA(1, 1), a1 + hstepA, voffA);
            PG8_WAIT_L(8); PG8_BAR; PG8_WAIT_L(0); PG8_MMA(0, 0, At, B0); PG8_BAR; PG8_SCHED;
            PG8_LDB(B1, 0, 1); PG8_STAGE(PG8_SB(0, 0), b2, voffB);
            PG8_BAR; PG8_WAIT_L(0); PG8_MMA(0, 1, At, B1); PG8_BAR;
            PG8_LDA(At, 0, 1); PG8_STAGE(PG8_SA(0, 0), a2, voffA);
            PG8_BAR; PG8_WAIT_L(0); PG8_MMA(1, 0, At, B0); PG8_BAR; PG8_SCHED;
            PG8_STAGE(PG8_SB(0, 1), b2 + hstep, voffB);
            PG8_WAIT_V(6); PG8_BAR; PG8_MMA(1, 1, At, B1); PG8_BAR;
            PG8_LDB(B0, 1, 0); PG8_SCHED; PG8_LDA(At, 1, 0); PG8_STAGE(PG8_SA(0, 1), a2 + hstepA, voffA);
            PG8_WAIT_L(8); PG8_BAR; PG8_WAIT_L(0); PG8_MMA(0, 0, At, B0); PG8_BAR; PG8_SCHED;
            PG8_LDB(B1, 1, 1); PG8_STAGE(PG8_SB(1, 0), b3, voffB);
            PG8_BAR; PG8_WAIT_L(0); PG8_MMA(0, 1, At, B1); PG8_BAR;
            PG8_LDA(At, 1, 1); PG8_STAGE(PG8_SA(1, 0), a3, voffA);
            PG8_BAR; PG8_WAIT_L(0); PG8_MMA(1, 0, At, B0); PG8_BAR; PG8_SCHED;
            PG8_STAGE(PG8_SB(1, 1), b3 + hstep, voffB);
            PG8_WAIT_V(6); PG8_BAR; PG8_MMA(1, 1, At, B1); PG8_BAR;
            }
        }
        if constexpr (ALIGN_EPI) { if (wr == 0) PG8_BAR; }
        if constexpr (F8) {
#pragma unroll
            for (int a = 0; a < 2; ++a)
#pragma unroll
                for (int b = 0; b < 2; ++b)
#pragma unroll
                    for (int m = 0; m < 4; ++m)
#pragma unroll
                        for (int n = 0; n < 2; ++n) acc[a][b][m][n] = __builtin_convertvector(acci[a][b][m][n], f32x4);
        }
        if constexpr (!Epi::AFTER_DRAIN) { E(acc, cur, wr, wc, fr, fq); S.done(cur); }
        if (!has_next) break;
#pragma unroll
        for (int a = 0; a < 2; ++a)
#pragma unroll
            for (int b = 0; b < 2; ++b)
#pragma unroll
                for (int m = 0; m < 4; ++m)
#pragma unroll
                    for (int n = 0; n < 2; ++n) { if constexpr (F8) acci[a][b][m][n] = (i32x4){0, 0, 0, 0}; else acc[a][b][m][n] = (f32x4){0.f, 0.f, 0.f, 0.f}; }
        cur = nxt; cA = nA; cB = nB; ++ui;
        if constexpr (ALIGN_EPI) { if (wr == 1) PG8_BAR; }
    }
    PG8_WAIT_V(0);
    if constexpr (!ALIGN_EPI) { if (wr == 0) PG8_BAR; }
    PG8_BAR;
    if constexpr (Epi::AFTER_DRAIN) { E.fused(acc, cur, wr, wc, fr, fq, lds, wid, lane); S.done(cur); }
#undef PG8_SA
#undef PG8_SB
#undef PG8_STAGE
#undef PG8_LDA
#undef PG8_LDB
#undef PG8_MMA
#undef PG8_WAIT_V
#undef PG8_WAIT_L
#undef PG8_BAR
#undef PG8_SCHED
}
}
namespace attn_body {
using bf16=__hip_bfloat16;
using bf16x8=__attribute__((ext_vector_type(8)))short;
using s16x4=__attribute__((ext_vector_type(4)))short;
using f32x16=__attribute__((ext_vector_type(16)))float;
using u32x4=__attribute__((ext_vector_type(4)))unsigned;
using f32x4v=__attribute__((ext_vector_type(4)))float;
constexpr int BATCH=8,NHEAD=8,SEQ=4096,D=64,QP=1536,KP=512;
constexpr int NW=8,QBLK=32,QB=QBLK*NW,KVBLK=64,NQB=SEQ/QB;
constexpr int ATTN_UNIT_ROWS=QB;
__device__ __forceinline__ int crow(int r,int hi){return (r&3)+8*(r>>2)+4*hi;}
#define SBAR() __builtin_amdgcn_sched_barrier(0)
__device__ __forceinline__ void cmask(f32x16&p0,f32x16&p1,int jb,int qrel,int hi){
  const float NEG=-INFINITY; int kb=64*jb+4*hi;
  #pragma unroll
  for(int r=0;r<16;++r){int kv=kb+(r&3)+8*(r>>2); if(kv>qrel)p0[r]=NEG; if(kv+32>qrel)p1[r]=NEG;}
}

constexpr int NSLOT=3, SLOTB=8192;
constexpr int LDS_K=0, LDS_V=NSLOT*SLOTB, LDS_WS=2*NSLOT*SLOTB, LDS_OST=LDS_WS+NW*64*4, LDS_BIAS=LDS_OST+NW*4096, LDS_BYTES=LDS_BIAS+SEQ*4;
constexpr float C2=0.125f*1.4426950408889634f;
__device__ __forceinline__ void glds16(const void*gsrc,unsigned lds_dst){unsigned keep;
  asm volatile("s_mov_b32 %0, m0\n\ts_mov_b32 m0, %2\n\ts_nop 0\n\tglobal_load_lds_dwordx4 %1, off\n\ts_mov_b32 m0, %0":"=&s"(keep):"v"(gsrc),"s"(lds_dst):"memory");}
__device__ __forceinline__ float max3f(float a,float b,float c){float r;asm("v_max3_f32 %0, %1, %2, %3":"=v"(r):"v"(a),"v"(b),"v"(c));return r;}
__device__ __forceinline__ float max2f(float a,float b){float r;asm("v_max_f32_e32 %0, %1, %2":"=v"(r):"v"(a),"v"(b));return r;}
__device__ __forceinline__ float fadd_s(float a,float b){float r;asm("v_add_f32_e32 %0, %1, %2":"=v"(r):"v"(a),"v"(b));return r;}
__device__ __forceinline__ float fsub_s(float a,float b){float r;asm("v_sub_f32_e32 %0, %1, %2":"=v"(r):"v"(a),"v"(b));return r;}
typedef float f32x2_t __attribute__((ext_vector_type(2))); typedef __bf16 bf16x2_t __attribute__((ext_vector_type(2)));
__device__ __forceinline__ unsigned cvtpk_s(float lo,float hi){f32x2_t v={lo,hi};bf16x2_t b=__builtin_convertvector(v,bf16x2_t);return __builtin_bit_cast(unsigned,b);}
#define WAIT_BAR(N) asm volatile("s_waitcnt vmcnt(" #N ") lgkmcnt(0)\n\ts_barrier":::"memory")

__device__ __forceinline__ void qkt(f32x16&p0,f32x16&p1,const char*Kslot,const bf16x8*qr,int r32,int hi){
  const char*kb=Kslot+hi*1024+r32*16;
  #pragma unroll
  for(int d0=0;d0<4;++d0){
    const bf16x8 b0=*reinterpret_cast<const bf16x8*>(kb+d0*2048);
    const bf16x8 b1=*reinterpret_cast<const bf16x8*>(kb+d0*2048+512);
    p0=__builtin_amdgcn_mfma_f32_32x32x16_bf16(b0,qr[d0],p0,0,0,0);p1=__builtin_amdgcn_mfma_f32_32x32x16_bf16(b1,qr[d0],p1,0,0,0);}
}
typedef __attribute__((address_space(3))) const char* lds_cptr;
typedef short v4i16_t __attribute__((ext_vector_type(4)));
__device__ __forceinline__ void kload8(bf16x8*kf,lds_cptr kp){
  kf[0]=*(const __attribute__((address_space(3))) bf16x8*)(kp);      kf[1]=*(const __attribute__((address_space(3))) bf16x8*)(kp+512);
  kf[2]=*(const __attribute__((address_space(3))) bf16x8*)(kp+2048); kf[3]=*(const __attribute__((address_space(3))) bf16x8*)(kp+2560);
  kf[4]=*(const __attribute__((address_space(3))) bf16x8*)(kp+4096); kf[5]=*(const __attribute__((address_space(3))) bf16x8*)(kp+4608);
  kf[6]=*(const __attribute__((address_space(3))) bf16x8*)(kp+6144); kf[7]=*(const __attribute__((address_space(3))) bf16x8*)(kp+6656);
}
__device__ __forceinline__ void kload2(bf16x8*kf,lds_cptr kp,int j){ kf[2*j]=*(const __attribute__((address_space(3))) bf16x8*)(kp+j*2048); kf[2*j+1]=*(const __attribute__((address_space(3))) bf16x8*)(kp+j*2048+512); }
__device__ __forceinline__ s16x4 vtr(lds_cptr p){ return __builtin_bit_cast(s16x4,__builtin_amdgcn_ds_read_tr16_b64_v4i16((__attribute__((address_space(3))) v4i16_t*)p)); }
__device__ __forceinline__ float rowmax(const f32x16&p0,const f32x16&p1){
  float a=max3f(p0[0],p0[1],p1[0]),b=max3f(p0[2],p0[3],p1[1]);a=max3f(a,p1[2],p1[3]);
  #pragma unroll
  for(int r=4;r<16;r+=4){a=max3f(a,p0[r],p0[r+1]);b=max3f(b,p0[r+2],p0[r+3]);a=max3f(a,p1[r],p1[r+1]);b=max3f(b,p1[r+2],p1[r+3]);}
  const float m=max2f(a,b);
  auto rr=__builtin_amdgcn_permlane32_swap(__float_as_uint(m),__float_as_uint(m),false,false);
  return max2f(__uint_as_float(rr[0]),__uint_as_float(rr[1]));
}
__device__ __forceinline__ void pv(f32x16*o,int vb,bf16x8 pa0,bf16x8 pa1,bf16x8 pa2,bf16x8 pa3){
  #pragma unroll
  for(int d0=0;d0<2;++d0){s16x4 lo[4],hi[4];
    #pragma unroll
    for(int ks=0;ks<4;++ks){
      asm volatile("ds_read_b64_tr_b16 %0,%1 offset:%c2":"=&v"(lo[ks]):"v"(vb),"i"(d0*4096+ks*1024):"memory");
      asm volatile("ds_read_b64_tr_b16 %0,%1 offset:%c2":"=&v"(hi[ks]):"v"(vb),"i"(d0*4096+ks*1024+512):"memory");}
    asm volatile("s_waitcnt lgkmcnt(0)":::"memory");SBAR();
    #define PK(k) (bf16x8){lo[k][0],lo[k][1],lo[k][2],lo[k][3],hi[k][0],hi[k][1],hi[k][2],hi[k][3]}
    o[d0]=__builtin_amdgcn_mfma_f32_32x32x16_bf16(pa0,PK(0),o[d0],0,0,0);
    o[d0]=__builtin_amdgcn_mfma_f32_32x32x16_bf16(pa1,PK(1),o[d0],0,0,0);
    o[d0]=__builtin_amdgcn_mfma_f32_32x32x16_bf16(pa2,PK(2),o[d0],0,0,0);
    o[d0]=__builtin_amdgcn_mfma_f32_32x32x16_bf16(pa3,PK(3),o[d0],0,0,0);
    #undef PK
  }
}

#ifndef ATTN_STORE16
#define ATTN_STORE16(p,v) (*(u32x4*)(p)=(v))
#endif
template<int THRL> __device__ __forceinline__ void attn_unit(int b,int h,int qb,const bf16*Q,const bf16*__restrict__ K,const bf16*__restrict__ V,bf16*O,const float*__restrict__ nbias,char*shm,int dry,float Tb){
  int tid_=threadIdx.x; asm volatile("":"+v"(tid_)); const int tid=tid_,lane=tid&63,r32=lane&31,hi=lane>>5; const int wid=__builtin_amdgcn_readfirstlane(tid>>6);
  const long rowbase=(long)b*SEQ; const int q0=qb*QB;
  int ts=0;
  { typedef __attribute__((address_space(3))) float* lfp; const lfp bl=(lfp)((__attribute__((address_space(3))) char*)shm+LDS_BIAS);
    const float thr=nbias[q0]-Tb; int cnt=0;
    for(int i=tid*4;i<q0+QB;i+=NW*64*4){ const f32x4v v=*reinterpret_cast<const f32x4v*>(nbias+i); *(__attribute__((address_space(3))) f32x4v*)(bl+i)=v;
      cnt+=(v[0]<thr?1:0)+(v[1]<thr?1:0)+(v[2]<thr?1:0)+(v[3]<thr?1:0); }
    #pragma unroll
    for(int o=1;o<64;o<<=1)cnt+=__shfl_xor(cnt,o);
    __attribute__((address_space(3))) int* cw=(__attribute__((address_space(3))) int*)((__attribute__((address_space(3))) char*)shm+LDS_WS);
    if(lane==0)cw[wid*64]=cnt;
    asm volatile("s_waitcnt lgkmcnt(0)\n\ts_barrier":::"memory");
    int tot=0;
    #pragma unroll
    for(int w=0;w<NW;++w)tot+=cw[w*64];
    tot=__builtin_amdgcn_readfirstlane(tot);
    ts=(tot>>6)&~1; const int tmax=(q0+QB)/KVBLK-4; ts=ts<tmax?ts:tmax; ts=ts<0?0:ts;
    asm volatile("s_waitcnt lgkmcnt(0)\n\ts_barrier":::"memory"); }
  const bf16*Qw=Q+(rowbase+q0+wid*QBLK)*QP+h*D;
  const bf16*Kh=K+(rowbase+(long)ts*KVBLK)*KP+h*D,*Vh=V+(rowbase+(long)ts*KVBLK)*KP+h*D;
  const unsigned lds0=(unsigned)(uintptr_t)shm;
  float*wsf=(float*)(shm+LDS_WS)+wid*64;
  const bf16*ksrc=Kh+(long)lane*KP+wid*8;
  const bf16*vsrc=Vh+(long)(16*(wid&3)+(lane>>2))*KP+(wid>>2)*32+(lane&3)*8;
  const unsigned kdst=lds0+LDS_K+wid*1024, vdst=lds0+LDS_V+wid*1024;
  #define DMA_K(t,slot) glds16(ksrc+(long)(t)*KVBLK*KP,(unsigned)__builtin_amdgcn_readfirstlane(kdst+(slot)))
  #define DMA_V(t,slot) glds16(vsrc+(long)(t)*KVBLK*KP,(unsigned)__builtin_amdgcn_readfirstlane(vdst+(slot)))
  const int vb0=(int)(lds0+LDS_V)+((lane>>4)&1)*32+(lane&3)*8+(4*hi+((lane&15)>>2))*64;
  const char*Kbase=shm+LDS_K; bf16x8 kf[8];
  const lds_cptr shm3=(lds_cptr)shm; const lds_cptr kp0=shm3+LDS_K+hi*1024+r32*16; const lds_cptr vp0=shm3+LDS_V+((lane>>4)&1)*32+(lane&3)*8+(4*hi+((lane&15)>>2))*64;
  const int NT=(q0+QB)/KVBLK-ts;
  DMA_K(0,0);DMA_V(0,0);DMA_K(1,SLOTB);
  bf16x8 qr[4];
  #pragma unroll
  for(int d0=0;d0<4;++d0)qr[d0]=*reinterpret_cast<const bf16x8*>(&Qw[(long)r32*QP+d0*16+hi*8]);
  float mhat=0.f,l_reg=0.f;f32x16 o[2];o[0]=f32x16{};o[1]=f32x16{};
  const int qrel=wid*QBLK+r32;
  #define CMASK(P0,P1,t) do{int jb_=(t)-(NT-4); if(jb_>=0)cmask(P0,P1,jb_,qrel,hi);}while(0)
  const __attribute__((address_space(3))) f32x4v* bias4=(const __attribute__((address_space(3))) f32x4v*)((__attribute__((address_space(3))) char*)shm+LDS_BIAS)+hi+16*ts;
  #define INITC(P0,P1,t) do{ _Pragma("unroll") for(int a_=0;a_<4;++a_){ const f32x4v v0_=bias4[16*(t)+2*a_], v1_=bias4[16*(t)+8+2*a_]; \
      _Pragma("unroll") for(int b_=0;b_<4;++b_){ P0[4*a_+b_]=v0_[b_]-mhat; P1[4*a_+b_]=v1_[b_]-mhat; } } }while(0)
  bool resc=false;
  #define START(P0,P1) do{ const float rm=rowmax(P0,P1); resc=false; \
    { const float dl=rm; mhat=fadd_s(mhat,dl); \
      _Pragma("unroll") for(int r=0;r<16;++r){P0[r]=fsub_s(P0[r],dl);P1[r]=fsub_s(P1[r],dl);} \
      } \
    _Pragma("unroll") for(int r=0;r<16;++r)P0[r]=__builtin_amdgcn_exp2f(P0[r]); }while(0)
  #define RESC() do{ if(resc){ asm volatile("s_waitcnt lgkmcnt(0)":::"memory"); \
      _Pragma("unroll") for(int d_=0;d_<2;++d_) _Pragma("unroll") for(int r=0;r<16;++r)o[d_][r]*=wsf[crow(r,hi)]; } }while(0)
  f32x16 pA0,pA1,pB0,pB1;
  int sl_prev=0,sl_cur=0,sl_next=SLOTB;
  #define ROT() do{sl_prev=sl_cur;sl_cur=sl_next;sl_next=(sl_next==(NSLOT-1)*SLOTB)?0:sl_next+SLOTB;}while(0)
  DMA_K(2,2*SLOTB);
  WAIT_BAR(3);
  INITC(pA0,pA1,0);qkt(pA0,pA1,Kbase,qr,r32,hi);asm volatile("s_nop 15\n\ts_nop 7":"+v"(pA0),"+v"(pA1));CMASK(pA0,pA1,0);
  START(pA0,pA1);
  _Pragma("unroll") for(int r=0;r<16;++r)pA1[r]=__builtin_amdgcn_exp2f(pA1[r]);
  WAIT_BAR(0);
  DMA_K(3,0);DMA_V(1,SLOTB);
  ROT();
  kload8(kf,kp0+sl_cur);
  WAIT_BAR(2);
  s16x4 vlo[8],vhi[8]; u32x4 pw0,pw1,pw2,pw3;
  #define PKW(P,B) cvtpk_s(P[B],P[B+1])
  #define PAF(k) __builtin_bit_cast(bf16x8,pw##k)
  #define VFR(i) (bf16x8){vlo[i][0],vlo[i][1],vlo[i][2],vlo[i][3],vhi[i][0],vhi[i][1],vhi[i][2],vhi[i][3]}
  #define PIN(x) asm volatile("":"+v"(x))
  #define MX3(a,b,c) __builtin_fmaxf(__builtin_fmaxf((a),(b)),(c))
  #define GAPA(MF,A0,A1,A2,A3,W0,W1,PW) do{ MF; sacc+=A0; sacc+=A1; sacc+=A2; sacc+=A3; PIN(sacc); W0; W1; PIN(PW); SBAR(); }while(0)
  #define EX(v) __builtin_amdgcn_exp2f(v)
  #define GAPB(MF,X,B) do{ MF; X[B]=EX(X[B]); X[B+1]=EX(X[B+1]); X[B+2]=EX(X[B+2]); X[B+3]=EX(X[B+3]); PIN(X); SBAR(); }while(0)
  #define VRD(i) do{ vlo[i]=vtr(vp_+(((i)>>2)*4096+((i)&3)*1024)); vhi[i]=vtr(vp_+(((i)>>2)*4096+((i)&3)*1024+512)); }while(0)
  #define KRD(G,j) do{ if(G){ kload2(kf,kp0+sl_next,j); SBAR(); } }while(0)
  #define STEP(C0,C1,P0,P1,t,GK,GV,GL) do{ SBAR(); INITC(C0,C1,t); SBAR(); \
    const lds_cptr vp_=vp0+sl_prev; \
    VRD(0); SBAR(); float sacc=(P0[0]+P0[1]); \
    GAPA(C0=__builtin_amdgcn_mfma_f32_32x32x16_bf16(kf[0],qr[0],C0,0,0,0), P0[2],P0[3],P0[4],P0[5],     pw0[0]=PKW(P0,0), pw0[1]=PKW(P0,2), pw0); \
    VRD(4); SBAR(); GAPA(C1=__builtin_amdgcn_mfma_f32_32x32x16_bf16(kf[1],qr[0],C1,0,0,0), P0[6],P0[7],P0[8],P0[9],     pw0[2]=PKW(P0,4), pw0[3]=PKW(P0,6), pw0); \
    VRD(1); SBAR(); GAPA(C0=__builtin_amdgcn_mfma_f32_32x32x16_bf16(kf[2],qr[1],C0,0,0,0),   P0[10],P0[11],P0[12],P0[13], pw1[0]=PKW(P0,8), pw1[1]=PKW(P0,10), pw1); \
    VRD(5); SBAR(); GAPA(C1=__builtin_amdgcn_mfma_f32_32x32x16_bf16(kf[3],qr[1],C1,0,0,0),   P0[14],P0[15],P1[0],P1[1],   pw1[2]=PKW(P0,12),pw1[3]=PKW(P0,14), pw1); \
    VRD(2); SBAR(); GAPA(C0=__builtin_amdgcn_mfma_f32_32x32x16_bf16(kf[4],qr[2],C0,0,0,0),   P1[2],P1[3],P1[4],P1[5],     pw2[0]=PKW(P1,0), pw2[1]=PKW(P1,2), pw2); \
    VRD(6); SBAR(); GAPA(C1=__builtin_amdgcn_mfma_f32_32x32x16_bf16(kf[5],qr[2],C1,0,0,0),   P1[6],P1[7],P1[8],P1[9],     pw2[2]=PKW(P1,4), pw2[3]=PKW(P1,6), pw2); \
    VRD(3); SBAR(); GAPA(C0=__builtin_amdgcn_mfma_f32_32x32x16_bf16(kf[6],qr[3],C0,0,0,0),   P1[10],P1[11],P1[12],P1[13], pw3[0]=PKW(P1,8), pw3[1]=PKW(P1,10), pw3); \
    VRD(7); SBAR(); GAPA(C1=__builtin_amdgcn_mfma_f32_32x32x16_bf16(kf[7],qr[3],C1,0,0,0),   P1[14],P1[15],0.f,0.f,       pw3[2]=PKW(P1,12),pw3[3]=PKW(P1,14), pw3); \
    l_reg+=sacc; \
    if(GK){DMA_K((t)+3,sl_cur);} if(GV){DMA_V((t)+1,sl_next);} \
    CMASK(C0,C1,t); \
    { float a=MX3(C0[0],C0[1],C1[0]),b=MX3(C0[2],C0[3],C1[1]); a=MX3(a,C1[2],C1[3]); \
      _Pragma("unroll") for(int r=4;r<16;r+=4){a=MX3(a,C0[r],C0[r+1]);b=MX3(b,C0[r+2],C0[r+3]);a=MX3(a,C1[r],C1[r+1]);b=MX3(b,C1[r+2],C1[r+3]);} \
      float rm=__builtin_fmaxf(a,b); { auto rr=__builtin_amdgcn_permlane32_swap(__float_as_uint(rm),__float_as_uint(rm),false,false); rm=__builtin_fmaxf(__uint_as_float(rr[0]),__uint_as_float(rr[1])); } \
      resc=false; \
      if(__builtin_expect(__any(rm>(float)THRL),0)){ const float dl=__builtin_fmaxf(rm,0.f); mhat+=dl; \
        _Pragma("unroll") for(int r=0;r<16;++r){C0[r]-=dl;C1[r]-=dl;} \
        const float f=__builtin_amdgcn_exp2f(-dl); l_reg*=f; if(hi==0)wsf[r32]=f; resc=true; } } \
    SBAR(); \
    GAPB(o[0]=__builtin_amdgcn_mfma_f32_32x32x16_bf16(PAF(0),VFR(0),o[0],0,0,0), C0,0); \
    GAPB(o[1]=__builtin_amdgcn_mfma_f32_32x32x16_bf16(PAF(0),VFR(4),o[1],0,0,0), C0,4); \
    KRD(GL,0); GAPB(o[0]=__builtin_amdgcn_mfma_f32_32x32x16_bf16(PAF(1),VFR(1),o[0],0,0,0), C0,8); \
    KRD(GL,1); GAPB(o[1]=__builtin_amdgcn_mfma_f32_32x32x16_bf16(PAF(1),VFR(5),o[1],0,0,0), C0,12); \
    KRD(GL,2); GAPB(o[0]=__builtin_amdgcn_mfma_f32_32x32x16_bf16(PAF(2),VFR(2),o[0],0,0,0), C1,0); \
    KRD(GL,3); GAPB(o[1]=__builtin_amdgcn_mfma_f32_32x32x16_bf16(PAF(2),VFR(6),o[1],0,0,0), C1,4); \
    GAPB(o[0]=__builtin_amdgcn_mfma_f32_32x32x16_bf16(PAF(3),VFR(3),o[0],0,0,0), C1,8); \
    GAPB(o[1]=__builtin_amdgcn_mfma_f32_32x32x16_bf16(PAF(3),VFR(7),o[1],0,0,0), C1,12); \
    }while(0)
  int t=1;
  #undef CMASK
  #define CMASK(P0,P1,t) do{}while(0)
  for(;t+5<NT;t+=2){
    STEP(pB0,pB1,pA0,pA1,t,true,true,true);     WAIT_BAR(2); RESC(); ROT();
    STEP(pA0,pA1,pB0,pB1,t+1,true,true,true);   WAIT_BAR(2); RESC(); ROT();
  }
  #undef CMASK
  #define CMASK(P0,P1,t) do{int jb_=(t)-(NT-4); if(jb_>=0)cmask(P0,P1,jb_,qrel,hi);}while(0)
  #define ENDW(tt) do{ if((tt)+3<NT){WAIT_BAR(2);} else if((tt)+2<NT){WAIT_BAR(1);} else {WAIT_BAR(0);} }while(0)
  for(;t+1<NT;t+=2){
    STEP(pB0,pB1,pA0,pA1,t,(t+3<NT),(t+1<NT),(t+1<NT));       ENDW(t);   RESC(); ROT();
    STEP(pA0,pA1,pB0,pB1,t+1,(t+4<NT),(t+2<NT),(t+2<NT));     ENDW(t+1); RESC(); ROT();
  }
  STEP(pB0,pB1,pA0,pA1,NT-1,false,false,false); RESC();
  { float sacc=pB0[0]+pB0[1]; _Pragma("unroll") for(int r=2;r<16;++r)sacc+=pB0[r]; _Pragma("unroll") for(int r=0;r<16;++r)sacc+=pB1[r]; l_reg+=sacc;
    pw0=(u32x4){PKW(pB0,0),PKW(pB0,2),PKW(pB0,4),PKW(pB0,6)};pw1=(u32x4){PKW(pB0,8),PKW(pB0,10),PKW(pB0,12),PKW(pB0,14)};pw2=(u32x4){PKW(pB1,0),PKW(pB1,2),PKW(pB1,4),PKW(pB1,6)};pw3=(u32x4){PKW(pB1,8),PKW(pB1,10),PKW(pB1,12),PKW(pB1,14)};
    SBAR(); pv(o,vb0+sl_cur,PAF(0),PAF(1),PAF(2),PAF(3)); }
  #undef PKW
  #undef PAF
  #undef VFR
  #undef PIN
  #undef MX3
  #undef GAPA
  #undef GAPB
  #undef EX
  #undef VRD
  #undef KRD
  #undef STEP
  #undef ENDW
  {auto rr=__builtin_amdgcn_permlane32_swap(__float_as_uint(l_reg),__float_as_uint(l_reg),false,false);l_reg=__uint_as_float(rr[0])+__uint_as_float(rr[1]);}
  if(hi==0)wsf[32+r32]=l_reg;asm volatile("s_waitcnt lgkmcnt(0)":::"memory");
  float rli[16];
  #pragma unroll
  for(int r=0;r<16;++r)rli[r]=__builtin_amdgcn_rcpf(wsf[32+crow(r,hi)]);
  bf16*Ow=O+(rowbase+q0+wid*QBLK)*QP+h*D;
  { bf16*stg=(bf16*)(shm+LDS_OST)+wid*2048;
    #pragma unroll
    for(int r=0;r<16;++r){const int orow=crow(r,hi);
      #pragma unroll
      for(int d0=0;d0<2;++d0)stg[orow*64+d0*32+r32]=__float2bfloat16(o[d0][r]*rli[r]);}
    asm volatile("s_waitcnt lgkmcnt(0)":::"memory");
    #pragma unroll
    for(int i=0;i<4;++i){const int row=i*8+(lane>>3),ch=lane&7; const u32x4 v=*(const u32x4*)(stg+row*64+ch*8); if(!dry){ATTN_STORE16(Ow+(long)row*QP+ch*8,v);}} }
  asm volatile("s_waitcnt lgkmcnt(0)\n\ts_barrier":::"memory");
  #undef DMA_K
  #undef DMA_V
  #undef CMASK
  #undef INITC
  #undef START
  #undef RESC
  #undef ROT
}
constexpr int ATTN_LDS_BYTES=LDS_BYTES;
struct AttnTensors { const bf16* Q; const bf16* K; const bf16* V; bf16* O; const float* nbias; const unsigned* nrm; };
template<int THRL=8> __device__ __forceinline__ void attn_phase(char*lds,const AttnTensors&T,int vcu,int G,int dry=0){
  for(int v=vcu;v<256;v+=G){ const int s=v&3,bh=v>>2;
    const float mq=__uint_as_float(__hip_atomic_load(T.nrm+2*bh,__ATOMIC_RELAXED,__HIP_MEMORY_SCOPE_AGENT)), mk=__uint_as_float(__hip_atomic_load(T.nrm+2*bh+1,__ATOMIC_RELAXED,__HIP_MEMORY_SCOPE_AGENT));
    const float Tb=44.0f+2.0f*(2.04f*sqrtf(mq*mk))+1.0f;
    for(int i=0;i<4;++i){ const int qb=(i==0)?s:(i==1)?7-s:(i==2)?8+s:15-s;
      attn_unit<THRL>(bh/NHEAD,bh%NHEAD,qb,T.Q,T.K,T.V,T.O,T.nbias+(long)bh*SEQ,lds,dry,Tb); } }
}
#undef SBAR
#undef WAIT_BAR
}
#define GAS __attribute__((address_space(1)))
#define LAS __attribute__((address_space(3)))
typedef unsigned short bf16;
typedef unsigned v4u __attribute__((ext_vector_type(4)));
typedef float f32x4 __attribute__((ext_vector_type(4)));
typedef short bf16x8 __attribute__((ext_vector_type(8)));
typedef GAS unsigned gu32;
typedef GAS unsigned long long gu64;
#define RLX_AGENT __ATOMIC_RELAXED, __HIP_MEMORY_SCOPE_AGENT
#define LDS_WAIT() asm volatile("s_waitcnt lgkmcnt(0)" ::: "memory")
#define VM_WAIT() asm volatile("s_waitcnt vmcnt(0)" ::: "memory")
__device__ __forceinline__ unsigned long long rt() { return __builtin_amdgcn_s_memrealtime(); }
__device__ __forceinline__ unsigned f2bf(float f) { unsigned u = __builtin_bit_cast(unsigned, f); return (u + 0x7fffu + ((u >> 16) & 1u)) >> 16; }
__device__ __forceinline__ unsigned pk2(float lo, float hi) { return f2bf(lo) | (f2bf(hi) << 16); }

#define XB_TMO      128
#define XB_XCNT(j)  (256  + 64 * (j))
#define XB_XSUB(j)  (1280 + 64 * (j))
#define XB_XGEN(j)  (2304 + 64 * (j))
#define XB_TOP      3328
#define XB_TOPGEN   3392
#define XCD_BAR_WORDS 3456
#define XB_SPIN_CAP (1u << 18)

__device__ __forceinline__ unsigned xb_ld(unsigned* p)              { return __hip_atomic_load(p, __ATOMIC_RELAXED, __HIP_MEMORY_SCOPE_AGENT); }
__device__ __forceinline__ unsigned xb_add(unsigned* p, unsigned v) { return __hip_atomic_fetch_add(p, v, __ATOMIC_RELAXED, __HIP_MEMORY_SCOPE_AGENT); }
__device__ __forceinline__ unsigned xb_xcc_id() { return (unsigned)__builtin_amdgcn_s_getreg((3 << 11) | 20) & 0xFu; }
#define XB_SPIN(cond, bar) do { unsigned _sp = 0; while (cond) { __builtin_amdgcn_s_sleep(1); \
    if ((++_sp & 255u) == 0u) { if (xb_ld(&(bar)[XB_TMO])) break; if (_sp > XB_SPIN_CAP) { atomicAdd(&(bar)[XB_TMO], 1u); break; } } } } while (0)

struct XcdBarrier {
    unsigned* bar; unsigned x;
    volatile LAS unsigned* st;
};

__device__ __forceinline__ XcdBarrier xcd_barrier_post(unsigned* bar, volatile LAS unsigned* st) {
    XcdBarrier b; b.bar = bar; b.x = xb_xcc_id(); b.st = st;
    if (threadIdx.x == 0) (void)xb_add(&bar[XB_XCNT(b.x)], 1u);
    return b;
}
__device__ __forceinline__ void xcd_barrier_complete(unsigned* bar, unsigned x, unsigned& nloc, unsigned& nx) {
    const unsigned G = gridDim.x * gridDim.y * gridDim.z;
    unsigned sum, cnt, mine, sp = 0u;
    for (;;) {
        sum = 0u; cnt = 0u; mine = 0u;
#pragma unroll
        for (unsigned j = 0; j < 16; ++j) { const unsigned c = xb_ld(&bar[XB_XCNT(j)]); sum += c; cnt += (c > 0u) ? 1u : 0u; mine = (j == x) ? c : mine; }
        if (sum == G) break;
        __builtin_amdgcn_s_sleep(1);
        if ((++sp & 255u) == 0u) { if (xb_ld(&bar[XB_TMO])) break; if (sp > XB_SPIN_CAP) { atomicAdd(&bar[XB_TMO], 1u); break; } }
    }
    nloc = mine > 0u ? mine : 1u; nx = cnt > 0u ? cnt : 1u;
}

__device__ __forceinline__ void xcd_barrier(const XcdBarrier& b) {
    asm volatile("s_waitcnt vmcnt(0)" ::: "memory");
    __syncthreads();
    if (threadIdx.x == 0) {
        unsigned* bar = b.bar;
        __builtin_amdgcn_s_waitcnt(0);
        unsigned nloc = b.st[0], nx = b.st[1];
        if (nloc == 0u) { xcd_barrier_complete(bar, b.x, nloc, nx); b.st[0] = nloc; b.st[1] = nx; }
        const unsigned old = xb_add(&bar[XB_XSUB(b.x)], 1u);
        const unsigned gen = old / nloc;
        if (old + 1u == (gen + 1u) * nloc) {
            __builtin_amdgcn_fence(__ATOMIC_RELEASE, "agent");
            asm volatile("s_waitcnt vmcnt(0)" ::: "memory");
            const unsigned og = xb_add(&bar[XB_TOP], 1u);
            const unsigned tg = og / nx;
            if (og + 1u == (tg + 1u) * nx) xb_add(&bar[XB_TOPGEN], 1u);
            else XB_SPIN(xb_ld(&bar[XB_TOPGEN]) == tg, bar);
            __builtin_amdgcn_fence(__ATOMIC_ACQUIRE, "agent");
            xb_add(&bar[XB_XGEN(b.x)], 1u);
            asm volatile("s_waitcnt vmcnt(0)" ::: "memory");
        } else {
            XB_SPIN(xb_ld(&bar[XB_XGEN(b.x)]) == gen, bar);
            __builtin_amdgcn_fence(__ATOMIC_ACQUIRE, "agent");
            asm volatile("s_waitcnt vmcnt(0)" ::: "memory");
        }
    }
    __syncthreads();
}
#define CW_XL_MASK(g) (20480 + 64 * (g))
#define CW_XL_SUB(g)  (21504 + 64 * (g))
#define CW_XL_GEN(g)  (22528 + 64 * (g))
__device__ __forceinline__ void group_barrier(unsigned* ctl, unsigned g, unsigned nloc) {
    asm volatile("s_waitcnt vmcnt(0)" ::: "memory");
    __syncthreads();
    if (threadIdx.x == 0) {
        __builtin_amdgcn_s_waitcnt(0);
        const unsigned old = xb_add(&ctl[CW_XL_SUB(g)], 1u);
        const unsigned gen = old / nloc;
        if (old + 1u == (gen + 1u) * nloc) xb_add(&ctl[CW_XL_GEN(g)], 1u);
        else XB_SPIN(xb_ld(&ctl[CW_XL_GEN(g)]) == gen, ctl + 4096);
        __builtin_amdgcn_fence(__ATOMIC_ACQUIRE, "agent");
        asm volatile("s_waitcnt vmcnt(0)" ::: "memory");
    }
    __syncthreads();
}
constexpr int NWAVES = 8;
#ifndef PROBE_MODE
#define PROBE_MODE 0
#endif
#ifndef MK_PER_PHASE
#define MK_PER_PHASE 0
#endif

constexpr float K_LOG2E_F = 1.4426950408889634f;
constexpr int NB = 8, SEQ = 4096, D = 1024, M = NB * SEQ, DFF = 2816, DEPTH = 4;
constexpr int NGU = 2 * DFF;
constexpr int NIN = 2816;
constexpr int KOUT = 1024;
constexpr int HID_P = 3072;
constexpr int ATT_P = 1536;
constexpr int IN_W = 2768;
constexpr int NPHASE = 2 + 8 * DEPTH;
constexpr size_t W_GU1 = 0, W_D1 = W_GU1 + (size_t)NGU * D, W_IN = W_D1 + (size_t)D * DFF, W_OUT = W_IN + (size_t)NIN * D, W_GU2 = W_OUT + (size_t)D * KOUT, W_D2 = W_GU2 + (size_t)NGU * D,
                 W_UK = W_D2 + (size_t)D * DFF, W_UVT = W_UK + 65536, W_LAYER = W_UVT + 65536;
constexpr size_t MiB = 1u << 20;
constexpr size_t WS_CTL = 0, CTL_ZERO_BYTES = 1 * MiB;
constexpr size_t WS_W = 2 * MiB;
constexpr size_t WS_WSC = 166 * MiB;
constexpr size_t WS_HB = 172 * MiB;
constexpr size_t WS_SSQ = 236 * MiB;
constexpr size_t WS_IDX = 238 * MiB;
constexpr size_t WS_CUM = 254 * MiB;
constexpr size_t WS_BIG = 256 * MiB;
constexpr size_t WS_ATT = WS_BIG, WS_QI = WS_BIG + 96 * MiB, WS_FK = WS_BIG + 128 * MiB, WS_FV = WS_BIG + 160 * MiB, WS_CR = WS_BIG + 192 * MiB, WS_CKV = WS_BIG + 208 * MiB,
                 WS_KI = WS_BIG + 216 * MiB, WS_WI = WS_BIG + 220 * MiB, WS_FL = WS_BIG + 221 * MiB, WS_HB8 = WS_BIG + 222 * MiB, WS_END = WS_HB8 + 32 * MiB;
static_assert(WS_W + 4 * W_LAYER * 2 <= WS_HB && (size_t)M * DFF * 2 <= 222 * MiB, "d_ws map");
constexpr int CW_BAR = 4096, CW_TOPKQ = 12288, CW_NRM = 16384;
constexpr int RING_OFF = 0, RING_BYTES = 139264;
constexpr int RSTD_OFF = 131072;
constexpr int LUT_OFF = RING_BYTES;
constexpr int MISC_OFF = LUT_OFF + 8320;
constexpr int LDS_BYTES = MISC_OFF + 256;
static_assert(LDS_BYTES <= 163840, "LDS");

struct Params { const float* in[18]; float* out; unsigned char* ws; int ph_lo, ph_hi; };
struct Frame {
    LAS unsigned char* lds; int tid, lane, wave, vcu, G, bx;
};
__device__ __forceinline__ float wave_sum(float v) {
#pragma unroll
    for (int o = 1; o < 64; o <<= 1) v += __shfl_xor(v, o);
    return v;
}
__device__ __forceinline__ void tr_load(float (&v)[32], const float* __restrict__ W, int ldw, int k0, int c0, int mode, const float* __restrict__ gain, int lane) {
    const int j = lane & 31;
    int col = c0 + j;
    if (mode == 1) col = (j < 8) ? (1216 + j) : (j < 16) ? (2760 + (j - 8)) : -1;
    else if (mode == 2) col = -1;
    const float* wp = W + (size_t)(k0 + (lane >> 5)) * ldw + (col >= 0 ? col : 0);
#pragma unroll
    for (int i = 0; i < 32; ++i) v[i] = (col >= 0) ? wp[(size_t)(2 * i) * ldw] : 0.f;
    if (gain) {
#pragma unroll
        for (int i = 0; i < 32; ++i) v[i] *= gain[k0 + 2 * i + (lane >> 5)];
    }
}
__device__ __forceinline__ void tr_store(const float (&v)[32], int q8, float qs, bf16* WT, int ldt, int n0, int dk0, LAS float* scr, int lane) {
    const int j = lane & 31;
#pragma unroll
    for (int i = 0; i < 32; ++i) scr[(2 * i + (lane >> 5)) * 33 + j] = q8 ? v[i] * qs : v[i];
    LDS_WAIT(); asm volatile("" ::: "memory");
    const int c = lane & 7;
#pragma unroll
    for (int jj = 0; jj < 4; ++jj) { const int n = (lane >> 3) + 8 * jj; const LAS float* s = scr + (8 * c) * 33 + n;
        if (q8) { pg8::u32x2 o; o.x = pg8::f8pk4(s[0 * 33], s[1 * 33], s[2 * 33], s[3 * 33], 1.0f); o.y = pg8::f8pk4(s[4 * 33], s[5 * 33], s[6 * 33], s[7 * 33], 1.0f);
            *(GAS pg8::u32x2*)((GAS unsigned char*)WT + (size_t)(n0 + n) * ldt + dk0 + 8 * c) = o; }
        else { v4u o; o.x = pk2(s[0 * 33], s[1 * 33]); o.y = pk2(s[2 * 33], s[3 * 33]); o.z = pk2(s[4 * 33], s[5 * 33]); o.w = pk2(s[6 * 33], s[7 * 33]);
            *(GAS v4u*)(WT + (size_t)(n0 + n) * ldt + dk0 + 8 * c) = o; } }
    LDS_WAIT(); asm volatile("" ::: "memory");
}
__device__ __forceinline__ void tr_item(const float* __restrict__ W, int ldw, int k0, int c0, int mode, const float* __restrict__ gain, bf16* WT, int ldt, int n0, int dk0, LAS float* scr, int lane) {
    float v[32]; tr_load(v, W, ldw, k0, c0, mode, gain, lane); tr_store(v, 0, 1.0f, WT, ldt, n0, dk0, scr, lane);
}
__device__ __forceinline__ void cb_item(const float* __restrict__ W, int ldw, int c0, int mode, const float* __restrict__ gain, bf16* WT, int n0, float* WSC, LAS float* scr, LAS float* cm, int wave, int lane) {
    float va[32], vb[32];
    tr_load(va, W, ldw, 128 * wave, c0, mode, gain, lane); tr_load(vb, W, ldw, 128 * wave + 64, c0, mode, gain, lane);
    float mx = 0.f;
#pragma unroll
    for (int i = 0; i < 32; ++i) mx = fmaxf(mx, fmaxf(fabsf(va[i]), fabsf(vb[i])));
    mx = fmaxf(mx, __shfl_xor(mx, 32));
    if (lane < 32) cm[wave * 32 + lane] = mx;
    __syncthreads();
    float m = 0.f;
#pragma unroll
    for (int w = 0; w < NWAVES; ++w) m = fmaxf(m, cm[w * 32 + (lane & 31)]);
    const float qs = m > 0.f ? 127.0f / m : 0.f;
    if (wave == 0 && lane < 32) WSC[n0 + lane] = m * (1.0f / 127.0f);
    tr_store(va, 1, qs, WT, D, n0, 128 * wave, scr, lane); tr_store(vb, 1, qs, WT, D, n0, 128 * wave + 64, scr, lane);
    __syncthreads();
}
__device__ __forceinline__ void cb2_item(const float* __restrict__ W, int c0, bf16* WT, int n0, float* WSC, LAS float* scr, LAS float* cm, int wave, int lane) {
    float mx = 0.f;
    for (int kb = wave; kb < DFF / 64; kb += 2 * NWAVES) { float v[32], v2[32]; const bool two = kb + NWAVES < DFF / 64;
        tr_load(v, W, D, 64 * kb, c0, 0, nullptr, lane); if (two) tr_load(v2, W, D, 64 * (kb + NWAVES), c0, 0, nullptr, lane);
#pragma unroll
        for (int i = 0; i < 32; ++i) mx = fmaxf(mx, fabsf(v[i]));
        if (two) {
#pragma unroll
            for (int i = 0; i < 32; ++i) mx = fmaxf(mx, fabsf(v2[i])); } }
    mx = fmaxf(mx, __shfl_xor(mx, 32));
    if (lane < 32) cm[wave * 32 + lane] = mx;
    __syncthreads();
    float m = 0.f;
#pragma unroll
    for (int w = 0; w < NWAVES; ++w) m = fmaxf(m, cm[w * 32 + (lane & 31)]);
    const float qs = m > 0.f ? 127.0f / m : 0.f;
    if (wave == 0 && lane < 32) WSC[n0 + lane] = m * (1.0f / 127.0f);
    for (int kb = wave; kb < DFF / 64; kb += 2 * NWAVES) { float v[32], v2[32]; const bool two = kb + NWAVES < DFF / 64;
        tr_load(v, W, D, 64 * kb, c0, 0, nullptr, lane); if (two) tr_load(v2, W, D, 64 * (kb + NWAVES), c0, 0, nullptr, lane);
        tr_store(v, 1, qs, WT, DFF, n0, 64 * kb, scr, lane); if (two) tr_store(v2, 1, qs, WT, DFF, n0, 64 * (kb + NWAVES), scr, lane); }
    __syncthreads();
}
constexpr int IT_FFN = 1408;
constexpr int IT_WIN = 88 * 16, IT_WOF = 32 * 16;
constexpr int IT_TR_LAYER = IT_WOF;
constexpr int IT_CB_LAYER = 5 * 88 + 2 * 32;
constexpr int WSC_GU1 = 0, WSC_GU2 = NGU, WSC_IN = 2 * NGU, WSC_D1 = 2 * NGU + NIN, WSC_D2 = WSC_D1 + D, WSC_LAYER = WSC_D2 + D;
typedef const __attribute__((address_space(4))) Params* kparams_t;
__device__ __forceinline__ void prologue_phase(kparams_t P, Frame& F) {
    LAS float* scr = (LAS float*)(F.lds + RING_OFF + F.wave * 16384);
    const int gw = F.vcu * NWAVES + F.wave, NGW = F.G * NWAVES;
    bf16* Wall = (bf16*)(P->ws + WS_W);
    for (int e = (F.vcu * NWAVES + F.wave) * 64 + F.lane; e < DEPTH * 65536; e += F.G * NWAVES * 64) {
        const int l = e >> 16, r = e & 65535;
        bf16* Wl = Wall + (size_t)l * W_LAYER;
        Wl[W_UK + r] = (bf16)f2bf(P->in[9][(size_t)l * 65536 + r]);
        const int h = r >> 13, d = (r >> 7) & 63, c = r & 127;
        Wl[W_UVT + r] = (bf16)f2bf(P->in[10][(size_t)l * 65536 + ((size_t)c * 8 + h) * 64 + d]);
    }
    { LAS float* cm = (LAS float*)(F.lds + RING_OFF + NWAVES * 16384);
      for (int it = F.vcu; it < DEPTH * IT_CB_LAYER; it += F.G) {
        const int l = it / IT_CB_LAYER; const int r = it % IT_CB_LAYER, mat = r / 88, nb = r % 88;
        bf16* Wl = Wall + (size_t)l * W_LAYER; float* wsc = (float*)(P->ws + WS_WSC) + (size_t)l * WSC_LAYER;
        if (r >= 5 * 88) { const int f = (r - 5 * 88) >> 5, nb2 = (r - 5 * 88) & 31;
            cb2_item(P->in[f ? 15 : 4] + (size_t)l * DFF * D, 32 * nb2, Wl + (f ? W_D2 : W_D1), 32 * nb2, wsc + (f ? WSC_D2 : WSC_D1), scr, cm, F.wave, F.lane); }
        else if (mat < 4) { const int f = mat >> 1, which = mat & 1;
            cb_item(P->in[(f ? 13 : 2) + which] + (size_t)l * D * DFF, DFF, 32 * nb, 0, P->in[f ? 12 : 1] + l * D, Wl + (f ? W_GU2 : W_GU1), 256 * (nb >> 2) + 32 * (nb & 3) + 128 * which, wsc + (f ? WSC_GU2 : WSC_GU1), scr, cm, F.wave, F.lane); }
        else { int c0 = 0, n0 = 0, mode = 0;
            if (nb < 16) { c0 = 32 * nb; n0 = 32 * nb; }
            else if (nb < 32) { c0 = 640 + 32 * (nb - 16); n0 = 512 + 32 * (nb - 16); }
            else if (nb < 80) { c0 = 1224 + 32 * (nb - 32); n0 = 1024 + 32 * (nb - 32); }
            else if (nb < 84) { c0 = 512 + 32 * (nb - 80); n0 = 2560 + 32 * (nb - 80); }
            else if (nb < 86) { c0 = 1152 + 32 * (nb - 84); n0 = 2688 + 32 * (nb - 84); }
            else if (nb == 86) { mode = 1; n0 = 2752; }
            else { mode = 2; n0 = 2784; }
            cb_item(P->in[6] + (size_t)l * D * IN_W, IN_W, c0, mode, P->in[5] + l * D, Wl + W_IN, n0, wsc + WSC_IN, scr, cm, F.wave, F.lane); }
      } }
    for (int it = gw; it < DEPTH * IT_TR_LAYER; it += NGW) {
        const int l = it / IT_TR_LAYER; int r = it % IT_TR_LAYER;
        bf16* Wl = Wall + (size_t)l * W_LAYER;
        { const int kb = r / 32, nb = r % 32, k0 = 64 * kb;
          tr_item(P->in[11] + (size_t)l * D * D, D, k0, 32 * nb, 0, nullptr, Wl + W_OUT, KOUT, 32 * nb, (k0 < 512) ? 512 + k0 : k0 - 512, scr, F.lane); }
    }
    bf16* HB = (bf16*)(P->ws + WS_HB); float* SSQ = (float*)(P->ws + WS_SSQ);
    for (int m0 = 4 * gw; m0 < M; m0 += 4 * NGW) {
        f32x4 v[4][4];
#pragma unroll
        for (int r = 0; r < 4; ++r) { const GAS f32x4* xr = (const GAS f32x4*)(P->in[0] + (size_t)(m0 + r) * D) + F.lane;
#pragma unroll
            for (int j = 0; j < 4; ++j) v[r][j] = xr[64 * j]; }
#pragma unroll
        for (int r = 0; r < 4; ++r) { const int m = m0 + r; float s = 0.f;
#pragma unroll
            for (int j = 0; j < 4; ++j) s += (v[r][j].x * v[r][j].x + v[r][j].y * v[r][j].y) + (v[r][j].z * v[r][j].z + v[r][j].w * v[r][j].w);
            s = wave_sum(s);
            GAS unsigned long long* o8 = (GAS unsigned long long*)(HB + (size_t)m * D) + F.lane;
#pragma unroll
            for (int j = 0; j < 4; ++j) o8[64 * j] = (unsigned long long)pk2(v[r][j].x, v[r][j].y) | ((unsigned long long)pk2(v[r][j].z, v[r][j].w) << 32);
            GAS unsigned* o4 = (GAS unsigned*)(P->ws + WS_HB8 + (size_t)m * D) + F.lane;
#pragma unroll
            for (int j = 0; j < 4; ++j) o4[64 * j] = pg8::f8pk4(v[r][j].x, v[r][j].y, v[r][j].z, v[r][j].w, pg8::F8_HS);
            if (F.lane < 16) SSQ[(size_t)m * 16 + F.lane] = (F.lane == 0) ? s : 0.f; }
    }
}
typedef unsigned short u16;
typedef unsigned u32x4t __attribute__((ext_vector_type(4)));
typedef float f32x2t __attribute__((ext_vector_type(2)));
constexpr int TOPK = 256;
__device__ __forceinline__ void scan_unit(const float* FL, const float* bfg, float* CUM, int bh, Frame& F) {
    const int b = bh >> 3, h = bh & 7; const float bf = bfg[h];
    const float* src = FL + ((size_t)b * SEQ + 8 * F.tid) * 8 + h;
    float pre[8]; float run = 0.f;
#pragma unroll
    for (int e = 0; e < 8; ++e) { const float x = src[e * 8] + bf; const float lf = fminf(x, 0.f) - log1pf(expf(-fabsf(x))); run += lf; pre[e] = run; }
    float inc = run;
#pragma unroll
    for (int o = 1; o < 64; o <<= 1) { const float t = __shfl_up(inc, o); if (F.lane >= o) inc += t; }
    LAS float* wt = (LAS float*)(F.lds + RING_OFF);
    __syncthreads();
    if (F.lane == 63) wt[F.wave] = inc;
    __syncthreads();
    float off = inc - run;
    for (int w = 0; w < F.wave; ++w) off += wt[w];
    float* dst = CUM + (size_t)bh * SEQ + 8 * F.tid;
    f32x4 o0, o1;
    o0[0] = -K_LOG2E_F * (off + pre[0]); o0[1] = -K_LOG2E_F * (off + pre[1]); o0[2] = -K_LOG2E_F * (off + pre[2]); o0[3] = -K_LOG2E_F * (off + pre[3]);
    o1[0] = -K_LOG2E_F * (off + pre[4]); o1[1] = -K_LOG2E_F * (off + pre[5]); o1[2] = -K_LOG2E_F * (off + pre[6]); o1[3] = -K_LOG2E_F * (off + pre[7]);
    *(f32x4*)dst = o0; *(f32x4*)(dst + 4) = o1;
    __syncthreads();
}
__device__ __forceinline__ void ckv_rows(const float* CR, const float* g, bf16* CKV, Frame& F) {
    const bool xb = F.G == 256;
    const int gw = xb ? (F.vcu & 31) * NWAVES + F.wave : F.vcu * NWAVES + F.wave, NGW = xb ? 32 * NWAVES : F.G * NWAVES, mb = xb ? (F.vcu >> 5) * SEQ : 0, me = xb ? SEQ : M;
    const float g0 = g[2 * F.lane], g1 = g[2 * F.lane + 1];
    for (int m0 = gw; m0 < me; m0 += 4 * NGW) {
        float v0[4], v1[4];
#pragma unroll
        for (int r = 0; r < 4; ++r) { const int m = mb + m0 + r * NGW; const f32x2t v = *(const f32x2t*)(CR + (size_t)m * 128 + 2 * F.lane); v0[r] = v[0]; v1[r] = v[1]; }
#pragma unroll
        for (int r = 0; r < 4; ++r) { const int m = mb + m0 + r * NGW; const float ss = wave_sum(v0[r] * v0[r] + v1[r] * v1[r]); const float rs = 1.0f / sqrtf(ss * (1.0f / 128.0f) + 1e-6f);
            *(GAS unsigned*)(CKV + (size_t)m * 128 + 2 * F.lane) = pk2(v0[r] * rs * g0, v1[r] * rs * g1); }
    }
}
__device__ __forceinline__ float tk_sum4(float t0, float t1, float t2, float t3) {
    float p;
    asm("v_add_f32 %0, %1, %2\n\tv_add_f32 %0, %0, %3\n\tv_add_f32 %0, %0, %4" : "=&v"(p) : "v"(t0), "v"(t1), "v"(t2), "v"(t3));
    return p;
}
#define TK_WAITV(n) asm volatile("s_waitcnt vmcnt(" #n ")" ::: "memory")
typedef float f32x16 __attribute__((ext_vector_type(16)));
constexpr int TK_RING = 0, TK_OST = 98304, TK_HIST = 106496, TK_CAND = 122880;
__device__ __forceinline__ bool topk_unit(const bf16* QI, const bf16* KI, const float* WI, u16* IDX, int b, int u, gu32* qctr, int G, LAS unsigned* nxw, bool pre, int& nxt, Frame& F) {
    const int lane = F.lane, wave = F.wave;
    const int t0 = 16 * u, tA = t0 + 2 * wave;
    const int m16 = lane & 15, g = lane >> 4, qs = g & 1, qi = ((lane >> 5) << 4) | m16;
    LAS unsigned char* ring = F.lds + RING_OFF + TK_RING;
    LAS u16* ost = (LAS u16*)(F.lds + RING_OFF + TK_OST + wave * 1024);
    unsigned got_ = 0u;
    if (F.tid == 0) { const unsigned old_ = __hip_atomic_fetch_add(qctr, 1u, __ATOMIC_RELAXED, __HIP_MEMORY_SCOPE_AGENT); got_ = (G == 256) ? (((32u + old_) << 3) | (unsigned)b) : (unsigned)G + old_; }
    if (t0 < TOPK) {
        u32x4t v; const unsigned k0 = 8u * (unsigned)qi;
        v.x = k0 | ((k0 + 1) << 16); v.y = (k0 + 2) | ((k0 + 3) << 16); v.z = (k0 + 4) | ((k0 + 5) << 16); v.w = (k0 + 6) | ((k0 + 7) << 16);
        *(GAS u32x4t*)(IDX + ((size_t)b * SEQ + tA + qs) * TOPK + 8 * qi) = v;
        if (F.tid == 0) *nxw = got_;
        __syncthreads();
        nxt = (int)*nxw;
        return false;
    }
    const int nch = (t0 + 16 + 255) >> 8;
    const bf16* qrow = QI + ((size_t)b * SEQ + tA + ((m16 >> 2) & 1)) * 512 + (4 * (m16 >> 3) + (m16 & 3)) * 64 + 8 * g;
    bf16x8 a0 = *(const bf16x8*)qrow, a1 = *(const bf16x8*)(qrow + 32);
    { const float wrow = WI[((size_t)b * SEQ + tA + ((m16 >> 2) & 1)) * 8 + 4 * (m16 >> 3) + (m16 & 3)];
      u32x4t r0 = __builtin_bit_cast(u32x4t, a0), r1 = __builtin_bit_cast(u32x4t, a1);
#pragma unroll
      for (int e = 0; e < 4; ++e) { r0[e] = pg8::cvt_pk_bf16(__uint_as_float(r0[e] << 16) * wrow, __uint_as_float(r0[e] & 0xffff0000u) * wrow);
                                    r1[e] = pg8::cvt_pk_bf16(__uint_as_float(r1[e] << 16) * wrow, __uint_as_float(r1[e] & 0xffff0000u) * wrow); }
      a0 = __builtin_bit_cast(bf16x8, r0); a1 = __builtin_bit_cast(bf16x8, r1); }
    const f32x4 wv = *(const f32x4*)(WI + ((size_t)b * SEQ + tA + qs) * 8 + 4 * (g >> 1));
    const float L0 = wv[0] > 0.f ? INFINITY : -INFINITY, L1 = wv[1] > 0.f ? INFINITY : -INFINITY, L2 = wv[2] > 0.f ? INFINITY : -INFINITY, L3 = wv[3] > 0.f ? INFINITY : -INFINITY;
    const int tq = tA + qs;
    f32x16 T0, T1, T2, T3, T4, T5, T6, T7;
    float vmin = INFINITY, vmax = -INFINITY;
    bool did = false;
#if PROBE_MODE == 5
    for (int rep_ = 0; rep_ < 2; ++rep_) {
#else
    {
#endif
    const size_t klane = (size_t)(8 * wave + (lane >> 3)) * 64 + ((lane & 7) ^ (lane >> 3)) * 8;
    const bf16* kp = KI + (size_t)b * SEQ * 64 + klane;
    const unsigned ring_a = (unsigned)(size_t)ring + (unsigned)wave * 1024u;
#define TK_ISSUE_P(ptr, slot) do { _Pragma("unroll") for (int pp = 0; pp < 4; ++pp) attn_body::glds16((ptr) + (size_t)pp * 64 * 64, (unsigned)__builtin_amdgcn_readfirstlane(ring_a + (unsigned)(slot) * 32768u + (unsigned)pp * 8192u)); } while (0)
#define TK_ISSUE(slot) TK_ISSUE_P(kp, slot)
    if (!pre) { TK_WAITV(0); TK_ISSUE(0); }
    if (nch > 1) { kp += 256 * 64; if (!pre) TK_ISSUE(1); }
#define TK_LDB(dst, jj) do { _Pragma("unroll") for (int hh = 0; hh < 2; ++hh) { const int row = 16 * (2 * (jj) + hh) + m16; \
        dst[hh][0] = *(const LAS bf16x8*)(kb + row * 128 + ((g ^ (row & 7)) * 16)); dst[hh][1] = *(const LAS bf16x8*)(kb + row * 128 + (((4 + g) ^ (row & 7)) * 16)); } } while (0)
#define TK_TERM(x, L) __builtin_amdgcn_fmed3f(x, 0.f, L)
#define TK_TILEPAIR(j, MASKED) { \
            if (j < 7) TK_LDB(bn, j + 1); \
            f32x4 c0 = {0.f, 0.f, 0.f, 0.f}, c1 = {0.f, 0.f, 0.f, 0.f}; \
            c0 = __builtin_amdgcn_mfma_f32_16x16x32_bf16(a0, bc[0][0], c0, 0, 0, 0); \
            c1 = __builtin_amdgcn_mfma_f32_16x16x32_bf16(a0, bc[1][0], c1, 0, 0, 0); \
            c0 = __builtin_amdgcn_mfma_f32_16x16x32_bf16(a1, bc[0][1], c0, 0, 0, 0); \
            c1 = __builtin_amdgcn_mfma_f32_16x16x32_bf16(a1, bc[1][1], c1, 0, 0, 0); \
            const float p0 = tk_sum4(TK_TERM(c0[0], L0), TK_TERM(c0[1], L1), TK_TERM(c0[2], L2), TK_TERM(c0[3], L3)); \
            const float p1 = tk_sum4(TK_TERM(c1[0], L0), TK_TERM(c1[1], L1), TK_TERM(c1[2], L2), TK_TERM(c1[3], L3)); \
              \
            const auto sw = __builtin_amdgcn_permlane32_swap(__float_as_uint(p0), __float_as_uint(p1), false, false); \
            const float tot = __uint_as_float(sw[0]) + __uint_as_float(sw[1]); \
            vmin = fminf(vmin, tot); \
            if (MASKED) { const int key = 256 * c + 32 * j + qi; sv[j] = (key <= tq) ? tot : -INFINITY; } else sv[j] = tot; \
            vmax = fmaxf(vmax, sv[j]); \
            if (j < 7) { bc[0][0] = bn[0][0]; bc[0][1] = bn[0][1]; bc[1][0] = bn[1][0]; bc[1][1] = bn[1][1]; } }
    for (int c = 0; c < nch; ++c) {
        if (c + 1 < nch) TK_WAITV(4); else TK_WAITV(0);
        __builtin_amdgcn_s_barrier(); asm volatile("" ::: "memory");
        if (c + 2 < nch) { kp += 256 * 64; TK_ISSUE((c + 2) % 3); }
        const LAS unsigned char* kb = ring + (c % 3) * 32768;
        bf16x8 bc[2][2], bn[2][2]; float sv[8];
        TK_LDB(bc, 0);
        if (c + 1 < nch) {
            TK_TILEPAIR(0, false) TK_TILEPAIR(1, false) TK_TILEPAIR(2, false) TK_TILEPAIR(3, false) TK_TILEPAIR(4, false) TK_TILEPAIR(5, false) TK_TILEPAIR(6, false) TK_TILEPAIR(7, false)
        } else {
            TK_TILEPAIR(0, true) TK_TILEPAIR(1, true) TK_TILEPAIR(2, true) TK_TILEPAIR(3, true) TK_TILEPAIR(4, true) TK_TILEPAIR(5, true) TK_TILEPAIR(6, true) TK_TILEPAIR(7, true)
        }
        T0[c] = sv[0]; T1[c] = sv[1]; T2[c] = sv[2]; T3[c] = sv[3]; T4[c] = sv[4]; T5[c] = sv[5]; T6[c] = sv[6]; T7[c] = sv[7];
    }
#undef TK_TILEPAIR
#undef TK_TERM
    if (F.tid == 0) *nxw = got_;
    asm volatile("s_waitcnt lgkmcnt(0)" ::: "memory"); __builtin_amdgcn_s_barrier(); asm volatile("" ::: "memory");
    nxt = (int)*nxw;
    const int nb = (nxt < 2048) ? (nxt & 7) : -1, nu = 255 - (nxt >> 3);
    if (nb >= 0 && 16 * nu >= TOPK) { const bf16* kq = KI + (size_t)nb * SEQ * 64 + klane; TK_ISSUE_P(kq, 0); if (((16 * nu + 16 + 255) >> 8) > 1) { TK_ISSUE_P(kq + 256 * 64, 1); } did = true; }
    }
#undef TK_ISSUE
#undef TK_ISSUE_P
#undef TK_LDB
#define TK_PASS(BODY, WB) _Pragma("unroll") for (int c = 0; c < 16; ++c) { if (c < nch) { float sv[8]; \
        sv[0] = T0[c]; sv[1] = T1[c]; sv[2] = T2[c]; sv[3] = T3[c]; sv[4] = T4[c]; sv[5] = T5[c]; sv[6] = T6[c]; sv[7] = T7[c]; \
        _Pragma("unroll") for (int j = 0; j < 8; ++j) { const int kbase = 256 * c + 32 * j; BODY(sv[j], j, kbase) } \
        if (WB) { T0[c] = sv[0]; T1[c] = sv[1]; T2[c] = sv[2]; T3[c] = sv[3]; T4[c] = sv[4]; T5[c] = sv[5]; T6[c] = sv[6]; T7[c] = sv[7]; } } }
    LAS unsigned* hist = (LAS unsigned*)(F.lds + RING_OFF + TK_HIST + wave * 2048);
    LAS unsigned* cand = (LAS unsigned*)(F.lds + RING_OFF + TK_CAND + wave * 1024) + qs * 128;
    { unsigned zz = 0u; asm volatile("" : "+v"(zz)); const u32x4t z = {zz, zz, zz, zz}; *(LAS u32x4t*)(hist + 8 * lane) = z; *(LAS u32x4t*)(hist + 8 * lane + 4) = z; *(LAS u32x4t*)((LAS unsigned char*)ost + 16 * lane) = z; }
#pragma unroll
    for (int o = 1; o < 16; o <<= 1) { vmin = fminf(vmin, __shfl_xor(vmin, o)); vmax = fmaxf(vmax, __shfl_xor(vmax, o)); }
    vmin = fminf(vmin, __shfl_xor(vmin, 32)); vmax = fmaxf(vmax, __shfl_xor(vmax, 32));
    const float scale = 16777000.0f / fmaxf(vmax - vmin, 1e-30f), off = 2.0f - vmin * scale;
    LAS unsigned* myh = hist + qs * 256;
#define TK_B_HIST(v, j, kbase) { unsigned uu; asm("v_cvt_u32_f32 %0, %1" : "=v"(uu) : "v"(fmaf(v, scale, off))); v = __uint_as_float(uu); \
        __hip_atomic_fetch_add(myh + (uu >> 16), 1u, __ATOMIC_RELAXED, __HIP_MEMORY_SCOPE_WORKGROUP); }
    TK_PASS(TK_B_HIST, 1)
#undef TK_B_HIST
    int B1, chi;
    { const u32x4t h0 = *(const LAS u32x4t*)(myh + 8 * qi), h1 = *(const LAS u32x4t*)(myh + 8 * qi + 4);
      const int hb[8] = {(int)h0.x, (int)h0.y, (int)h0.z, (int)h0.w, (int)h1.x, (int)h1.y, (int)h1.z, (int)h1.w};
      const int tot = ((hb[0] + hb[1]) + (hb[2] + hb[3])) + ((hb[4] + hb[5]) + (hb[6] + hb[7]));
      int S = tot;
#pragma unroll
      for (int o = 1; o < 16; o <<= 1) { const int tt = __shfl_down(S, o); if (m16 + o < 16) S += tt; }
      { const int hi_tot = __shfl(S, 32 + 16 * qs); if (lane < 32) S += hi_tot; }
      int cum = S - tot, Bl = -1, cl = 0;
#pragma unroll
      for (int k = 7; k >= 0; --k) { if (Bl < 0) { if (cum + hb[k] >= TOPK) { Bl = 8 * qi + k; cl = cum; } else cum += hb[k]; } }
      const bool finder = (S >= TOPK) && (S - tot < TOPK);
      const unsigned long long fm = __ballot(finder) & (0x0000FFFF0000FFFFull << (16 * qs));
      const int src = (int)__ffsll((long long)fm) - 1;
      B1 = __shfl(Bl, src); chi = __shfl(cl, src); }
    const unsigned UL = (unsigned)B1 << 16, UH = UL + 65536u;
    LAS unsigned* ccnt = myh;
    *ccnt = 0u;
    unsigned gm0 = 0u, gm1 = 0u, gm2 = 0u, gm3 = 0u;
#define TK_B_COLLECT(v, j, kbase) { const unsigned d = __float_as_uint(v) - UL; \
        if (d < 65536u) { const unsigned slot = __hip_atomic_fetch_add(ccnt, 1u, __ATOMIC_RELAXED, __HIP_MEMORY_SCOPE_WORKGROUP);     \
            if (slot < 128u) cand[slot] = (d << 12) | (unsigned)(4095 - (kbase + qi)); } }
#define TK_CGROUP(K, GM) if (nch > 4 * (K)) { \
        _Pragma("unroll") for (int cc = 0; cc < 4; ++cc) { const int c = 4 * (K) + cc; if (c < nch) { float sv[8]; bool anyeq = false; \
            sv[0] = T0[c]; sv[1] = T1[c]; sv[2] = T2[c]; sv[3] = T3[c]; sv[4] = T4[c]; sv[5] = T5[c]; sv[6] = T6[c]; sv[7] = T7[c]; \
            _Pragma("unroll") for (int j = 0; j < 8; ++j) { const unsigned uu = __float_as_uint(sv[j]); GM = (GM << 1) | ((uu >= UH) ? 1u : 0u); anyeq |= ((uu - UL) < 65536u); } \
            if (__any(anyeq)) { _Pragma("unroll") for (int j = 0; j < 8; ++j) { const int kbase = 256 * c + 32 * j; TK_B_COLLECT(sv[j], j, kbase) } } } } \
        { const int cend_ = (nch < 4 * (K) + 4) ? nch : 4 * (K) + 4; GM <<= 8 * (4 * (K) + 4 - cend_); } }
    TK_CGROUP(0, gm0) TK_CGROUP(1, gm1) TK_CGROUP(2, gm2) TK_CGROUP(3, gm3)
#undef TK_CGROUP
#undef TK_B_COLLECT
    LAS u16* oq = ost + qs * TOPK;
    const int cbA = __builtin_amdgcn_readfirstlane((int)hist[0]), cbB = __builtin_amdgcn_readfirstlane((int)hist[256]);
    const int mA = cbA < 128 ? cbA : 128, mB = cbB < 128 ? cbB : 128, mm = qs ? mB : mA, mx = mA > mB ? mA : mB;
    { const int cnt = (__popc(gm0) + __popc(gm1)) + (__popc(gm2) + __popc(gm3));
      int inc = cnt;
#pragma unroll
      for (int o = 1; o < 16; o <<= 1) { const int tt = __shfl_up(inc, o); if (m16 >= o) inc += tt; }
      { const int lo_tot = __shfl(inc, 15 + 16 * qs); if (lane >= 32) inc += lo_tot; }
      int pos = inc - cnt;
#define TK_WRITE_WORD(K, GM) { unsigned m_ = GM; while (__any(m_ != 0u)) { if (m_) { const int lz = __clz((int)m_); oq[pos] = (u16)(32 * (32 * (K) + lz) + qi); ++pos; m_ &= 0x7fffffffu >> lz; } } }
      TK_WRITE_WORD(0, gm0) TK_WRITE_WORD(1, gm1) TK_WRITE_WORD(2, gm2) TK_WRITE_WORD(3, gm3)
#undef TK_WRITE_WORD
    }
    { const int need = TOPK - chi;
      unsigned ck[4]; int rk[4];
#pragma unroll
      for (int e = 0; e < 4; ++e) { ck[e] = (qi + 32 * e < mm) ? cand[qi + 32 * e] : 0u; rk[e] = 0; }
      for (int i = 0; i < mx; i += 4) { const u32x4t v4 = *(const LAS u32x4t*)(cand + i);
#pragma unroll
          for (int q = 0; q < 4; ++q) { const unsigned v = v4[q]; const bool live = i + q < mm;
#pragma unroll
              for (int e = 0; e < 4; ++e) rk[e] += (live && v > ck[e]) ? 1 : 0; } }
#pragma unroll
      for (int e = 0; e < 4; ++e) if ((qi + 32 * e < mm) && rk[e] < need) oq[chi + rk[e]] = (u16)(4095u - (ck[e] & 4095u)); }
    LDS_WAIT(); asm volatile("" ::: "memory");
    *(GAS u32x4t*)(IDX + ((size_t)b * SEQ + tA) * TOPK + 8 * lane) = *(const LAS u32x4t*)((const LAS unsigned char*)ost + 16 * lane);
    LDS_WAIT(); asm volatile("" ::: "memory");
#undef TK_PASS
    return did;
}
#undef TK_WAITV
constexpr int SP_WAVE_BYTES = 17408;
__device__ __forceinline__ unsigned sp_swz(unsigned row) { return ((row & 3u) << 2) | ((row >> 2) & 3u); }
__device__ __forceinline__ unsigned sp_off(unsigned row, unsigned ch) { return 256u * (4u * (row & 7u) + (row >> 3)) + 16u * (ch ^ sp_swz(row)); }
__device__ __forceinline__ void sp_dma8(const bf16* base, unsigned lds_dst, unsigned msk, unsigned k0, unsigned k1, unsigned k2, unsigned k3, unsigned k4, unsigned k5, unsigned k6, unsigned k7,
                                        unsigned l0, unsigned l1, unsigned l2, unsigned l3, unsigned l4, unsigned l5, unsigned l6, unsigned l7) {
    unsigned keep;
    asm volatile("s_waitcnt lgkmcnt(0)\n\ts_mov_b32 %0, m0\n\ts_mov_b32 m0, %9\n\tv_and_or_b32 %1, %1, %11, %12\n\ts_nop 1\n\t"
                 "global_load_lds_dwordx4 %1, %10\n\ts_add_u32 m0, m0, 0x400\n\tv_and_or_b32 %2, %2, %11, %13\n\t"
                 "global_load_lds_dwordx4 %2, %10\n\ts_add_u32 m0, m0, 0x400\n\tv_and_or_b32 %3, %3, %11, %14\n\t"
                 "global_load_lds_dwordx4 %3, %10\n\ts_add_u32 m0, m0, 0x400\n\tv_and_or_b32 %4, %4, %11, %15\n\t"
                 "global_load_lds_dwordx4 %4, %10\n\ts_add_u32 m0, m0, 0x400\n\tv_and_or_b32 %5, %5, %11, %16\n\t"
                 "global_load_lds_dwordx4 %5, %10\n\ts_add_u32 m0, m0, 0x400\n\tv_and_or_b32 %6, %6, %11, %17\n\t"
                 "global_load_lds_dwordx4 %6, %10\n\ts_add_u32 m0, m0, 0x400\n\tv_and_or_b32 %7, %7, %11, %18\n\t"
                 "global_load_lds_dwordx4 %7, %10\n\ts_add_u32 m0, m0, 0x400\n\tv_and_or_b32 %8, %8, %11, %19\n\t"
                 "global_load_lds_dwordx4 %8, %10\n\ts_mov_b32 m0, %0"
                 : "=&s"(keep), "+v"(k0), "+v"(k1), "+v"(k2), "+v"(k3), "+v"(k4), "+v"(k5), "+v"(k6), "+v"(k7)
                 : "s"(lds_dst), "s"(base), "s"(msk), "v"(l0), "v"(l1), "v"(l2), "v"(l3), "v"(l4), "v"(l5), "v"(l6), "v"(l7) : "memory", "scc");
}
typedef short v4i16_t __attribute__((ext_vector_type(4)));
__device__ __forceinline__ void build_lut(const float* rel_bias, Frame& F) {
    LAS float* lut = (LAS float*)(F.lds + LUT_OFF);
    for (int e = F.tid; e < 130 * 16; e += NWAVES * 64) { const int d = (e >> 4) - 1, hh = e & 15; int bk = d < 0 ? 0 : d;
        if (d >= 16) { bk = 16 + (int)(logf((float)d * (1.0f / 16.0f)) / 2.0794415416798357f * 16.0f); bk = bk < 31 ? bk : 31; }
        const float v = (hh < 8) ? rel_bias[bk * 8 + hh] * K_LOG2E_F : 0.f;
        lut[e] = (d < 0) ? -INFINITY : v; }
}
__device__ __forceinline__ void sparse_phase(bf16* ATT, const bf16* CKV, const u16* IDX, const bf16* Wl, int q0, int qstride, int nq, Frame& F, int dry = 0) {
    typedef unsigned u32x2t __attribute__((ext_vector_type(2)));
    const int lane = F.lane, n = lane & 15, g = lane >> 4;
    LAS unsigned char* wl = F.lds + RING_OFF + F.wave * SP_WAVE_BYTES;
    const LAS unsigned char* lutn = F.lds + LUT_OFF + 64 + 4 * n;
    const unsigned rA0 = 8u * (n >> 2) + (n & 3u), rA1 = rA0 + 4u;
    const unsigned q4 = (unsigned)n >> 2, p4 = (unsigned)n & 3u;
    u32x2t ixn = {0u, 0u};
    bf16x8 qf[4];
    const unsigned wl_a = (unsigned)(size_t)wl;
    unsigned lt[8];
#pragma unroll
    for (int i = 0; i < 8; ++i) lt[i] = 16u * ((unsigned)n ^ sp_swz(8u * g + i));
#define SP_KEY(KW, i) (((i) & 1) ? ((KW)[(i) >> 1] >> 16) : ((KW)[(i) >> 1] & 0xffffu))
#define SP_ISSUE(bufoff, KW, CB) sp_dma8((CB), (unsigned)__builtin_amdgcn_readfirstlane(wl_a + (unsigned)(bufoff)), 0x00ffff00u, \
        (KW)[0] << 8, (KW)[0] >> 8, (KW)[1] << 8, (KW)[1] >> 8, (KW)[2] << 8, (KW)[2] >> 8, (KW)[3] << 8, (KW)[3] >> 8, lt[0], lt[1], lt[2], lt[3], lt[4], lt[5], lt[6], lt[7])
#define SP_LANDED() asm volatile("s_waitcnt vmcnt(0)" ::: "memory")
#define SP_LOADQ(dst, row) do { _Pragma("unroll") for (int s = 0; s < 4; ++s) { bf16x8 z = {0, 0, 0, 0, 0, 0, 0, 0}; dst[s] = (n < 8) ? *(const bf16x8*)(ATT + (size_t)(row) * 1536 + 512 + n * 128 + 32 * s + 8 * g) : z; } } while (0)
    const int base0 = q0 - F.wave, hh = F.wave;
    LAS unsigned* qctr = (LAS unsigned*)(F.lds + MISC_OFF + 64);
    if (F.tid == 0) *qctr = 8u;
    __syncthreads();
    if (nq == 16) {
        typedef unsigned u32x2t __attribute__((ext_vector_type(2)));
        bf16x8 wa[8][2], qa[8][2];
        const bf16* uk = Wl + W_UK + (size_t)n * 512 + hh * 64 + 8 * g;
#pragma unroll
        for (int ct = 0; ct < 8; ++ct) { wa[ct][0] = *(const bf16x8*)(uk + (size_t)ct * 16 * 512); wa[ct][1] = *(const bf16x8*)(uk + (size_t)ct * 16 * 512 + 32); }
#pragma unroll
        for (int tt = 0; tt < 8; ++tt) { const bf16* ar = ATT + (size_t)(base0 + tt + n * qstride) * 1536 + 512 + hh * 64 + 8 * g; qa[tt][0] = *(const bf16x8*)ar; qa[tt][1] = *(const bf16x8*)(ar + 32); }
        asm volatile("s_waitcnt vmcnt(0)" ::: "memory"); __syncthreads();
#pragma unroll
        for (int tt = 0; tt < 8; ++tt) { bf16* ar = ATT + (size_t)(base0 + tt + n * qstride) * 1536 + 512 + hh * 128 + 4 * g;
#pragma unroll
            for (int ct = 0; ct < 8; ++ct) { f32x4 d = {0.f, 0.f, 0.f, 0.f};
                d = __builtin_amdgcn_mfma_f32_16x16x32_bf16(wa[ct][0], qa[tt][0], d, 0, 0, 0);
                d = __builtin_amdgcn_mfma_f32_16x16x32_bf16(wa[ct][1], qa[tt][1], d, 0, 0, 0);
                u32x2t w; w.x = pk2(d[0], d[1]); w.y = pk2(d[2], d[3]);
                *(GAS u32x2t*)(ar + 16 * ct) = w; } }
        asm volatile("s_waitcnt vmcnt(0)" ::: "memory"); __syncthreads();
    }
    *(LAS u32x2t*)(wl + 16384 + 8 * lane) = *(const GAS u32x2t*)(IDX + (size_t)q0 * TOPK + 4 * lane);
    SP_LOADQ(qf, q0);
    LDS_WAIT(); asm volatile("" ::: "memory");
    u32x4t kw0 = *(const LAS u32x4t*)(wl + 16384 + 16 * g), kw1 = *(const LAS u32x4t*)(wl + 16384 + 64 + 16 * g), kw2 = kw1;
    { const bf16* cb = CKV + (size_t)(q0 >> 12) * SEQ * 128; SP_ISSUE(0, kw0, cb); }
    unsigned one2; asm volatile("s_mov_b32 %0, 0x3f803f80" : "=s"(one2));
    u32x4t onew = {one2, one2, one2, one2};
    asm volatile("" : "+v"(onew));
    const bf16x8 ones = __builtin_bit_cast(bf16x8, onew);
    int row = q0, rown = q0; bool more = true;
    for (int k = 0; more; ++k) {
        const int t = row & (SEQ - 1);
        { unsigned nx_ = 0u; if (lane == 0) nx_ = __hip_atomic_fetch_add(qctr, 1u, __ATOMIC_RELAXED, __HIP_MEMORY_SCOPE_WORKGROUP);
          const int nxt = __builtin_amdgcn_readfirstlane((int)nx_); more = nxt < 8 * nq; rown = base0 + (nxt & 7) + (nxt >> 3) * qstride; }
        const LAS unsigned char* idxs_b = wl + 16384 + (k & 1) * 512 + 16 * g;
        const LAS unsigned char* idxn_b = wl + 16384 + ((k + 1) & 1) * 512 + 16 * g;
        LAS unsigned char* idxn = wl + 16384 + ((k + 1) & 1) * 512;
        const bf16* cb = CKV + (size_t)(row >> 12) * SEQ * 128; const bf16* cbn = CKV + (size_t)(rown >> 12) * SEQ * 128;
        float m_run = 0.f;
        f32x4 O[8], Ls = {0.f, 0.f, 0.f, 0.f};
#pragma unroll
        for (int cc = 0; cc < 8; ++cc) O[cc] = (f32x4){0.f, 0.f, 0.f, 0.f};
#define SP_STEP(c) { \
        LAS unsigned char* cur = wl + ((c) & 1) * 8192; \
        SP_LANDED();     \
        if ((c) < 7) SP_ISSUE((((c) + 1) & 1) * 8192, kw1, cb); else if (more) SP_ISSUE(0, kw1, cbn); \
        kw2 = *(const LAS u32x4t*)(((c) < 6 ? idxs_b : idxn_b) + 64 * (((c) + 2) & 7)); \
        if ((c) == 0 && more) ixn = *(const GAS u32x2t*)(IDX + (size_t)rown * TOPK + 4 * lane); \
        if ((c) == 4 && more) *(LAS u32x2t*)(idxn + 8 * lane) = ixn; \
          \
        float bsm[8]; \
        _Pragma("unroll") for (int i = 0; i < 8; ++i) { const int dist = t - (int)SP_KEY(kw0, i); const int dcl = dist < -1 ? -1 : (dist > 128 ? 128 : dist); \
            const float lv = *(const LAS float*)(lutn + 64 * dcl); bsm[i] = ((c) == 0) ? lv : lv - m_run; } \
          \
        bf16x8 kq[4][2]; \
        _Pragma("unroll") for (int s = 0; s < 4; ++s) { kq[s][0] = *(const LAS bf16x8*)(cur + sp_off(rA0, 4 * s + g)); kq[s][1] = *(const LAS bf16x8*)(cur + sp_off(rA1, 4 * s + g)); } \
        asm volatile("" ::: "memory"); \
        f32x4 S0 = {bsm[0], bsm[1], bsm[2], bsm[3]}, S1 = {bsm[4], bsm[5], bsm[6], bsm[7]}; \
        _Pragma("unroll") for (int s = 0; s < 4; ++s) { \
            S0 = __builtin_amdgcn_mfma_f32_16x16x32_bf16(kq[s][0], qf[s], S0, 0, 0, 0); \
            S1 = __builtin_amdgcn_mfma_f32_16x16x32_bf16(kq[s][1], qf[s], S1, 0, 0, 0); } \
        if ((c) == 7 && more) SP_LOADQ(qf, rown);     \
        v4i16_t vlo[8], vhi[8]; \
        _Pragma("unroll") for (int cc = 0; cc < 8; ++cc) { \
            vlo[cc] = __builtin_amdgcn_ds_read_tr16_b64_v4i16((LAS v4i16_t*)(cur + sp_off(8u * g + q4, 2u * cc + (p4 >> 1)) + 8u * (p4 & 1u))); \
            vhi[cc] = __builtin_amdgcn_ds_read_tr16_b64_v4i16((LAS v4i16_t*)(cur + sp_off(8u * g + 4u + q4, 2u * cc + (p4 >> 1)) + 8u * (p4 & 1u))); } \
        asm volatile("" ::: "memory"); \
          \
        float mx = fmaxf(fmaxf(fmaxf(S0[0], S0[1]), fmaxf(S0[2], S0[3])), fmaxf(fmaxf(S1[0], S1[1]), fmaxf(S1[2], S1[3]))); \
        if ((c) == 0) {     \
            { const auto r1 = __builtin_amdgcn_permlane16_swap(__float_as_uint(mx), __float_as_uint(mx), false, false); mx = fmaxf(__uint_as_float(r1[0]), __uint_as_float(r1[1])); } \
            { const auto r2 = __builtin_amdgcn_permlane32_swap(__float_as_uint(mx), __float_as_uint(mx), false, false); mx = fmaxf(__uint_as_float(r2[0]), __uint_as_float(r2[1])); } \
            m_run = mx; \
            _Pragma("unroll") for (int e = 0; e < 4; ++e) { S0[e] -= mx; S1[e] -= mx; } \
        } else if (__any(mx > 16.0f)) {     \
            mx = fmaxf(mx, __shfl_xor(mx, 16)); mx = fmaxf(mx, __shfl_xor(mx, 32)); \
                \
            const float dl = fmaxf(mx, 0.f); const float alpha = __builtin_amdgcn_exp2f(-dl); \
            m_run += dl; \
            _Pragma("unroll") for (int e = 0; e < 4; ++e) { S0[e] -= dl; S1[e] -= dl; } \
            const float al0 = __shfl(alpha, 4 * g), al1 = __shfl(alpha, 4 * g + 1), al2 = __shfl(alpha, 4 * g + 2), al3 = __shfl(alpha, 4 * g + 3); \
            Ls[0] *= al0; Ls[1] *= al1; Ls[2] *= al2; Ls[3] *= al3; \
            _Pragma("unroll") for (int cc = 0; cc < 8; ++cc) { O[cc][0] *= al0; O[cc][1] *= al1; O[cc][2] *= al2; O[cc][3] *= al3; } } \
        u32x4t pw; \
        pw.x = pg8::cvt_pk_bf16(__builtin_amdgcn_exp2f(S0[0]), __builtin_amdgcn_exp2f(S0[1])); pw.y = pg8::cvt_pk_bf16(__builtin_amdgcn_exp2f(S0[2]), __builtin_amdgcn_exp2f(S0[3])); \
        pw.z = pg8::cvt_pk_bf16(__builtin_amdgcn_exp2f(S1[0]), __builtin_amdgcn_exp2f(S1[1])); pw.w = pg8::cvt_pk_bf16(__builtin_amdgcn_exp2f(S1[2]), __builtin_amdgcn_exp2f(S1[3])); \
        const bf16x8 pa = __builtin_bit_cast(bf16x8, pw); \
        _Pragma("unroll") for (int cc = 0; cc < 8; ++cc) { \
            const bf16x8 vb = {vlo[cc][0], vlo[cc][1], vlo[cc][2], vlo[cc][3], vhi[cc][0], vhi[cc][1], vhi[cc][2], vhi[cc][3]}; \
            O[cc] = __builtin_amdgcn_mfma_f32_16x16x32_bf16(pa, vb, O[cc], 0, 0, 0); } \
        Ls = __builtin_amdgcn_mfma_f32_16x16x32_bf16(pa, ones, Ls, 0, 0, 0);     \
        kw0 = kw1; kw1 = kw2; }
        SP_STEP(0) SP_STEP(1) SP_STEP(2) SP_STEP(3) SP_STEP(4) SP_STEP(5) SP_STEP(6) SP_STEP(7)
#undef SP_STEP
        const float i0 = __builtin_amdgcn_rcpf(Ls[0]), i1 = __builtin_amdgcn_rcpf(Ls[1]), i2 = __builtin_amdgcn_rcpf(Ls[2]), i3 = __builtin_amdgcn_rcpf(Ls[3]);
        if (g < 2) {
            LAS bf16* st = (LAS bf16*)(wl + 8192) + (4 * g) * 128 + n;
#pragma unroll
            for (int cc = 0; cc < 8; ++cc) {
                const unsigned w01 = pg8::cvt_pk_bf16(O[cc][0] * i0, O[cc][1] * i1), w23 = pg8::cvt_pk_bf16(O[cc][2] * i2, O[cc][3] * i3);
                LAS u16* s16 = (LAS u16*)st;
                s16[0 * 128 + 16 * cc] = (u16)(w01 & 0xffffu); s16[1 * 128 + 16 * cc] = (u16)(w01 >> 16);
                s16[2 * 128 + 16 * cc] = (u16)(w23 & 0xffffu); s16[3 * 128 + 16 * cc] = (u16)(w23 >> 16);
            }
        }
        LDS_WAIT(); asm volatile("" ::: "memory");
        if (!dry) {
#pragma unroll
            for (int i = 0; i < 2; ++i) *(GAS u32x4t*)(ATT + (size_t)row * 1536 + 512 + 8 * (lane + 64 * i)) = *(const LAS u32x4t*)(wl + 8192 + 16 * (lane + 64 * i));
        }
        LDS_WAIT(); asm volatile("" ::: "memory");
        row = rown;
    }
    asm volatile("s_waitcnt vmcnt(0)" ::: "memory"); __syncthreads();
    if (nq == 16 && !dry) {
        typedef unsigned u32x2t __attribute__((ext_vector_type(2)));
        bf16x8 wa[4][4];
        const bf16* uvt = Wl + W_UVT + ((size_t)hh * 64 + n) * 128 + 8 * g;
#pragma unroll
        for (int dt = 0; dt < 4; ++dt)
#pragma unroll
            for (int s = 0; s < 4; ++s) wa[dt][s] = *(const bf16x8*)(uvt + (size_t)dt * 16 * 128 + 32 * s);
#pragma unroll
        for (int half = 0; half < 2; ++half) {
            bf16x8 ol[4][4];
#pragma unroll
            for (int t4 = 0; t4 < 4; ++t4) { const bf16* ar = ATT + (size_t)(base0 + 4 * half + t4 + n * qstride) * 1536 + 512 + hh * 128 + 8 * g;
#pragma unroll
                for (int s = 0; s < 4; ++s) ol[t4][s] = *(const bf16x8*)(ar + 32 * s); }
            asm volatile("s_waitcnt vmcnt(0)" ::: "memory"); __syncthreads();
#pragma unroll
            for (int t4 = 0; t4 < 4; ++t4) { bf16* ar = ATT + (size_t)(base0 + 4 * half + t4 + n * qstride) * 1536 + 512 + hh * 64 + 4 * g;
#pragma unroll
                for (int dt = 0; dt < 4; ++dt) { f32x4 d = {0.f, 0.f, 0.f, 0.f};
#pragma unroll
                    for (int s = 0; s < 4; ++s) d = __builtin_amdgcn_mfma_f32_16x16x32_bf16(wa[dt][s], ol[t4][s], d, 0, 0, 0);
                    u32x2t w; w.x = pk2(d[0], d[1]); w.y = pk2(d[2], d[3]);
                    *(GAS u32x2t*)(ar + 16 * dt) = w; } }
        }
    }
#undef SP_ISSUE
#undef SP_KEY
#undef SP_LANDED
#undef SP_LOADQ
}
__device__ __forceinline__ void final_norm_phase(float* out, const bf16* HB, const float* SSQ, const float* g, Frame& F) {
    const bool xb = F.G == 256;
    const int gw = xb ? (F.vcu >> 5) * SEQ + (F.vcu & 31) * NWAVES + F.wave : F.vcu * NWAVES + F.wave, NGW = xb ? 32 * NWAVES : F.G * NWAVES, me = xb ? ((F.vcu >> 5) + 1) * SEQ : M;
    f32x4 gv[4];
#pragma unroll
    for (int j = 0; j < 2; ++j) { gv[2 * j] = *(const f32x4*)(g + 512 * j + 8 * F.lane); gv[2 * j + 1] = *(const f32x4*)(g + 512 * j + 8 * F.lane + 4); }
    for (int m = gw; m < me; m += NGW) {
        const float rs = pg8::row_rstd(SSQ, m);
#pragma unroll
        for (int j = 0; j < 2; ++j) { const v4u b = *(const GAS v4u*)(HB + (size_t)m * D + 512 * j + 8 * F.lane);
            const f32x4 v0 = {__uint_as_float(b.x << 16), __uint_as_float(b.x & 0xffff0000u), __uint_as_float(b.y << 16), __uint_as_float(b.y & 0xffff0000u)};
            const f32x4 v1 = {__uint_as_float(b.z << 16), __uint_as_float(b.z & 0xffff0000u), __uint_as_float(b.w << 16), __uint_as_float(b.w & 0xffff0000u)};
            float* o = out + (size_t)m * D + 512 * j + 8 * F.lane;
            *(GAS f32x4*)o = v0 * rs * gv[2 * j]; *(GAS f32x4*)(o + 4) = v1 * rs * gv[2 * j + 1]; }
    }
}
__global__ void __launch_bounds__(NWAVES * 64, 2) trunk_fwd(Params P) {
    extern __shared__ __attribute__((aligned(16))) unsigned char lds_raw[];
    Frame F;
    F.lds = (LAS unsigned char*)lds_raw;
    F.tid = threadIdx.x; F.lane = F.tid & 63; F.wave = __builtin_amdgcn_readfirstlane(F.tid >> 6);
    F.G = gridDim.x; { const int bx = blockIdx.x; F.vcu = (F.G % 8 == 0) ? (bx % 8) * (F.G / 8) + bx / 8 : bx; }
    volatile LAS unsigned* MISC = (volatile LAS unsigned*)(F.lds + MISC_OFF);
    for (int u = F.tid; u < 64; u += NWAVES * 64) MISC[u] = 0u;
    __syncthreads();
    typedef const __attribute__((address_space(4))) Params* kparams_t;
#define KP() ({ kparams_t kp_ = (kparams_t)__builtin_amdgcn_kernarg_segment_ptr(); asm volatile("" : "+s"(kp_)); kp_; })
    const int lo = P.ph_lo, hi = P.ph_hi;
#if MK_PER_PHASE
#define GRID_BAR() do { } while (0)
#else
    XcdBarrier bar = xcd_barrier_post((unsigned*)((gu32*)(P.ws + WS_CTL) + CW_BAR), MISC + 8);
    if (threadIdx.x == 0 && gridDim.x == 256) (void)__hip_atomic_fetch_or((unsigned*)((gu32*)(P.ws + WS_CTL)) + CW_XL_MASK(blockIdx.x & 7), 1u << xb_xcc_id(), __ATOMIC_RELAXED, __HIP_MEMORY_SCOPE_AGENT);
#define GRID_BAR() xcd_barrier(bar)
#endif
#define IN(k) (lo <= (k) && (k) < hi)
#define MKF() Frame Fp; { int t_ = threadIdx.x, g_ = gridDim.x, b_ = blockIdx.x; asm volatile("" : "+v"(t_), "+s"(g_), "+s"(b_)); Fp.lds = F.lds; Fp.tid = t_; Fp.lane = t_ & 63; Fp.wave = __builtin_amdgcn_readfirstlane(t_ >> 6); \
        Fp.G = g_; Fp.bx = b_; Fp.vcu = (g_ % 8 == 0) ? (b_ % 8) * (g_ / 8) + b_ / 8 : b_; }
#define SEAM(k) do { if (IN(k) && IN((k) + 1)) GRID_BAR(); } while (0)
#define SEAM_G(k) do { if (IN(k) && IN((k) + 1)) { if (MISC[12]) { kparams_t kp_ = KP(); int b_ = blockIdx.x; asm volatile("" : "+s"(b_)); group_barrier((unsigned*)((gu32*)(kp_->ws + WS_CTL)), (unsigned)b_ & 7u, 32u); } else GRID_BAR(); } } while (0)

#if PROBE_MODE == 4
    if (IN(0)) { kparams_t kp = KP(); MKF(); prologue_phase(kp, Fp); VM_WAIT(); __syncthreads(); }
#endif
    if (IN(0)) { kparams_t kp = KP(); MKF(); prologue_phase(kp, Fp); VM_WAIT(); __syncthreads(); }
    SEAM(0);
#if !MK_PER_PHASE
    { if (threadIdx.x == 0) { unsigned ok = (gridDim.x == 256) ? 1u : 0u;
          if (ok) { const unsigned* ctl_ = (const unsigned*)((gu32*)(P.ws + WS_CTL));
#pragma unroll
              for (int g = 0; g < 8; ++g) { const unsigned mk_ = __hip_atomic_load(ctl_ + CW_XL_MASK(g), __ATOMIC_RELAXED, __HIP_MEMORY_SCOPE_AGENT); ok &= (__popc(mk_) == 1) ? 1u : 0u; } }
          MISC[12] = ok; }
      __syncthreads(); }
#endif
    for (int l = 0; l < DEPTH; ++l) {
        const int pb = 1 + 8 * l;
        if (IN(pb + 0)) { kparams_t kp = KP(); MKF(); unsigned char* ws = kp->ws; const bf16* Wl = (const bf16*)(ws + WS_W) + (size_t)l * W_LAYER;
            pg8::Gemm g{(const bf16*)(ws + WS_HB8), Wl + W_GU1, M, NGU, D / 2, D / 2};     pg8::StaticOrder S; S.init(M, NGU, Fp.G, Fp.bx);
            pg8::EpiSwiGLU E{ws + WS_BIG, HID_P, (const float*)(ws + WS_SSQ), Fp.lds + RSTD_OFF, (const float*)(ws + WS_WSC) + (size_t)l * WSC_LAYER + WSC_GU1};
            if (Fp.lane == 0) *(LAS float*)(Fp.lds + RSTD_OFF + Fp.wave * 1024 + 512) = __int_as_float(-1);
            pg8::gemm_phase<pg8::EpiSwiGLU, pg8::StaticOrder, true, true, true>(Fp.lds + RING_OFF, g, S, E);
            }
        SEAM_G(pb + 0);
        if (IN(pb + 1)) { kparams_t kp = KP(); MKF(); unsigned char* ws = kp->ws; const bf16* Wl = (const bf16*)(ws + WS_W) + (size_t)l * W_LAYER;
            pg8::Gemm g{(const bf16*)(ws + WS_BIG), Wl + W_D1, M, D, DFF / 2, HID_P / 2}; pg8::StaticOrder S; S.init(M, D, Fp.G, Fp.bx);
            pg8::EpiRes<(long)WS_HB8 - (long)WS_HB, true> E{(bf16*)(ws + WS_HB), (float*)(ws + WS_SSQ), 0.5f / pg8::F8_HID, (const float*)(ws + WS_WSC) + (size_t)l * WSC_LAYER + WSC_D1};
            pg8::gemm_phase<pg8::EpiRes<(long)WS_HB8 - (long)WS_HB, true>, pg8::StaticOrder, true, true, true>(Fp.lds + RING_OFF, g, S, E); }
        SEAM_G(pb + 1);
        if (IN(pb + 2)) { kparams_t kp = KP(); MKF(); unsigned char* ws = kp->ws; const bf16* Wl = (const bf16*)(ws + WS_W) + (size_t)l * W_LAYER;
            pg8::Gemm g{(const bf16*)(ws + WS_HB8), Wl + W_IN, M, NIN, D / 2, D / 2}; pg8::StaticOrder S; S.init(M, NIN, Fp.G, Fp.bx);
            pg8::EpiProj E{(bf16*)(ws + WS_ATT), (bf16*)(ws + WS_QI), (bf16*)(ws + WS_FK), (bf16*)(ws + WS_FV), (bf16*)(ws + WS_KI), (float*)(ws + WS_CR), (float*)(ws + WS_WI), (float*)(ws + WS_FL), (const float*)(ws + WS_SSQ), Fp.lds + RSTD_OFF, (const float*)(ws + WS_WSC) + (size_t)l * WSC_LAYER + WSC_IN, (unsigned*)(ws + WS_CTL) + CW_NRM + l * 128};
            if (Fp.lane == 0) *(LAS float*)(Fp.lds + RSTD_OFF + Fp.wave * 1024 + 512) = __int_as_float(-1);
            pg8::gemm_phase<pg8::EpiProj, pg8::StaticOrder, true, true, true>(Fp.lds + RING_OFF, g, S, E);
            }
        SEAM_G(pb + 2);
        if (IN(pb + 3)) {
            { kparams_t kp = KP(); MKF(); unsigned char* ws = kp->ws;
              for (int v = Fp.vcu; v < 256; v += Fp.G) scan_unit((const float*)(ws + WS_FL), kp->in[7] + l * 8, (float*)(ws + WS_CUM), v >> 2, Fp);
              ckv_rows((const float*)(ws + WS_CR), kp->in[8] + l * 128, (bf16*)(ws + WS_CKV), Fp); }
            VM_WAIT(); __syncthreads();
            if (threadIdx.x == 0) { __builtin_amdgcn_fence(__ATOMIC_ACQUIRE, "agent"); VM_WAIT(); }
            __syncthreads();
            { kparams_t kp = KP(); MKF(); unsigned char* ws = kp->ws; bf16* ATT = (bf16*)(ws + WS_ATT);
              const attn_body::AttnTensors AT{(const attn_body::bf16*)ATT, (const attn_body::bf16*)(ws + WS_FK), (const attn_body::bf16*)(ws + WS_FV), (attn_body::bf16*)ATT, (const float*)(ws + WS_CUM), (const unsigned*)(ws + WS_CTL) + CW_NRM + l * 128};
              attn_body::attn_phase<64>((char*)lds_raw + RING_OFF, AT, Fp.vcu, Fp.G); }
            VM_WAIT(); __syncthreads();
            { kparams_t kp = KP(); MKF(); unsigned char* ws = kp->ws;
              const bool xq = Fp.G == 256;
              gu32* qctr = (gu32*)(ws + WS_CTL) + CW_TOPKQ + 64 * (xq ? 8 * l + (Fp.vcu >> 5) : l);
              bool pre = false; int cur = xq ? (((Fp.vcu & 31) << 3) | (Fp.vcu >> 5)) : Fp.vcu, par = 0;
              while (cur < 2048) { int nxt = 2048;
                  pre = topk_unit((const bf16*)(ws + WS_QI), (const bf16*)(ws + WS_KI), (const float*)(ws + WS_WI), (u16*)(ws + WS_IDX), cur & 7, 255 - (cur >> 3), qctr, Fp.G,
                                  (LAS unsigned*)(Fp.lds + MISC_OFF + 96) + par, pre, nxt, Fp);
                  cur = nxt; par ^= 1; } }
            VM_WAIT(); __syncthreads();
        }
        SEAM_G(pb + 3);
        if (IN(pb + 4)) {
            { kparams_t kp = KP(); MKF(); build_lut(kp->in[16], Fp); }
            __syncthreads();
            { kparams_t kp = KP(); MKF(); unsigned char* ws = kp->ws;
#if PROBE_MODE == 2
              { const int dry_ = (int)(kp->ph_hi > 0); sparse_phase((bf16*)(ws + WS_ATT), (const bf16*)(ws + WS_CKV), (const u16*)(ws + WS_IDX), (const bf16*)(ws + WS_W) + (size_t)l * W_LAYER, Fp.vcu * NWAVES + Fp.wave, Fp.G * NWAVES, M / (Fp.G * NWAVES), Fp, dry_); }
#endif
              const bool xb = Fp.G == 256;
              sparse_phase((bf16*)(ws + WS_ATT), (const bf16*)(ws + WS_CKV), (const u16*)(ws + WS_IDX), (const bf16*)(ws + WS_W) + (size_t)l * W_LAYER,
                           xb ? (Fp.vcu >> 5) * SEQ + (Fp.vcu & 31) * NWAVES + Fp.wave : Fp.vcu * NWAVES + Fp.wave, xb ? 256 : Fp.G * NWAVES, xb ? 16 : M / (Fp.G * NWAVES), Fp); }
            VM_WAIT(); __syncthreads();
        }
        SEAM_G(pb + 4);
        if (IN(pb + 5)) { kparams_t kp = KP(); MKF(); unsigned char* ws = kp->ws; const bf16* Wl = (const bf16*)(ws + WS_W) + (size_t)l * W_LAYER;
            pg8::Gemm g{(const bf16*)(ws + WS_ATT), Wl + W_OUT, M, D, KOUT, ATT_P}; pg8::StaticOrder S; S.init(M, D, Fp.G, Fp.bx);
            pg8::EpiRes<(long)WS_HB8 - (long)WS_HB> E{(bf16*)(ws + WS_HB), (float*)(ws + WS_SSQ), 1.0f, nullptr};
            pg8::gemm_phase<pg8::EpiRes<(long)WS_HB8 - (long)WS_HB>, pg8::StaticOrder, true, true>(Fp.lds + RING_OFF, g, S, E); }
        SEAM_G(pb + 5);
        if (IN(pb + 6)) { kparams_t kp = KP(); MKF(); unsigned char* ws = kp->ws; const bf16* Wl = (const bf16*)(ws + WS_W) + (size_t)l * W_LAYER;
            pg8::Gemm g{(const bf16*)(ws + WS_HB8), Wl + W_GU2, M, NGU, D / 2, D / 2}; pg8::StaticOrder S; S.init(M, NGU, Fp.G, Fp.bx);
            pg8::EpiSwiGLU E{ws + WS_BIG, HID_P, (const float*)(ws + WS_SSQ), Fp.lds + RSTD_OFF, (const float*)(ws + WS_WSC) + (size_t)l * WSC_LAYER + WSC_GU2};
            if (Fp.lane == 0) *(LAS float*)(Fp.lds + RSTD_OFF + Fp.wave * 1024 + 512) = __int_as_float(-1);
            pg8::gemm_phase<pg8::EpiSwiGLU, pg8::StaticOrder, true, true, true>(Fp.lds + RING_OFF, g, S, E); }
        SEAM_G(pb + 6);
        if (IN(pb + 7)) { kparams_t kp = KP(); MKF(); unsigned char* ws = kp->ws; const bf16* Wl = (const bf16*)(ws + WS_W) + (size_t)l * W_LAYER;
            pg8::Gemm g{(const bf16*)(ws + WS_BIG), Wl + W_D2, M, D, DFF / 2, HID_P / 2}; pg8::StaticOrder S; S.init(M, D, Fp.G, Fp.bx);
            pg8::EpiRes<(long)WS_HB8 - (long)WS_HB, true> E{(bf16*)(ws + WS_HB), (float*)(ws + WS_SSQ), 0.5f / pg8::F8_HID, (const float*)(ws + WS_WSC) + (size_t)l * WSC_LAYER + WSC_D2};
            pg8::gemm_phase<pg8::EpiRes<(long)WS_HB8 - (long)WS_HB, true>, pg8::StaticOrder, true, true, true>(Fp.lds + RING_OFF, g, S, E); }
        SEAM_G(pb + 7);
    }
    if (IN(NPHASE - 1)) { kparams_t kp = KP(); MKF(); final_norm_phase(kp->out, (const bf16*)(kp->ws + WS_HB), (const float*)(kp->ws + WS_SSQ), kp->in[17], Fp); }
#undef IN
#undef MKF
#undef SEAM
#undef GRID_BAR
}

extern "C" void kernel_launch(void* const* d_in, const int* in_sizes, int n_in, void* d_out, int out_size, void* d_ws, size_t ws_size, hipStream_t stream) {
    static int grid = 0;
    if (grid == 0) {
        if (n_in != 18 || in_sizes[0] != M * D || out_size != M * D || ws_size < WS_END) { fprintf(stderr, "kernel_launch: unexpected shapes (n_in %d, in0 %d, out %d, ws %zu < %zu); nothing launched\n", n_in, n_in > 0 ? in_sizes[0] : -1, out_size, ws_size, (size_t)WS_END); grid = -1; return; }
        int dev = 0, cus = 0, per_cu = 0;
        if (hipGetDevice(&dev) != hipSuccess || hipDeviceGetAttribute(&cus, hipDeviceAttributeMultiprocessorCount, dev) != hipSuccess) { grid = -1; return; }
        if (hipFuncSetAttribute((const void*)trunk_fwd, hipFuncAttributeMaxDynamicSharedMemorySize, LDS_BYTES) != hipSuccess) { fprintf(stderr, "kernel_launch: hipFuncSetAttribute failed\n"); grid = -1; return; }
        if (hipOccupancyMaxActiveBlocksPerMultiprocessor(&per_cu, (const void*)trunk_fwd, NWAVES * 64, LDS_BYTES) != hipSuccess || per_cu < 1) { fprintf(stderr, "kernel_launch: occupancy query says %d\n", per_cu); }
        (void)hipGetLastError();
        grid = cus;
    }
    if (grid < 0) return;
    if (hipMemsetAsync((char*)d_ws + WS_CTL, 0, CTL_ZERO_BYTES, stream) != hipSuccess) return;
    Params p{};
    for (int i = 0; i < 18; ++i) p.in[i] = (const float*)d_in[i];
    p.out = (float*)d_out; p.ws = (unsigned char*)d_ws;
#if MK_PER_PHASE
    for (int ph = 0; ph < NPHASE; ++ph) { p.ph_lo = ph; p.ph_hi = ph + 1; hipLaunchKernelGGL(trunk_fwd, dim3(grid), dim3(NWAVES * 64), LDS_BYTES, stream, p); }
#else
    p.ph_lo = 0; p.ph_hi = NPHASE;
    hipLaunchKernelGGL(trunk_fwd, dim3(grid), dim3(NWAVES * 64), LDS_BYTES, stream, p);
#endif
}
```

```cpp
#include <hip/hip_runtime.h>
#include <hip/hip_bf16.h>
#include <cstdio>
#include <cstdint>
#include <cmath>
namespace pg8 {
#define PG8_LAS __attribute__((address_space(3)))
typedef unsigned short bf16_t;
typedef short bf16x8 __attribute__((ext_vector_type(8)));
typedef float f32x4 __attribute__((ext_vector_type(4)));
typedef unsigned u32x4 __attribute__((ext_vector_type(4)));
constexpr int BM = 256, BK = 64, HALF = 128, HTB = HALF * BK * 2  , STAGE_BYTES = 8 * HTB, NXCD = 8, WGM = 8;

__host__ __device__ __forceinline__ int lds_byte(int r, int c) { const int st = (r >> 4) * 2 + (c >> 5), rr = r & 15, cc = c & 31, ob = rr * 64 + cc * 2; return st * 1024 + (ob ^ (((ob >> 9) & 1) << 5)); }
__host__ __device__ __forceinline__ void stage_rc(int b, int& R, int& C) { const int st = b / 1024, sb = b % 1024, swz = sb ^ (((sb >> 9) & 1) << 5); R = (st >> 1) * 16 + swz / 64; C = (st & 1) * 32 + (swz % 64) / 2; }
__host__ __device__ __forceinline__ int perm32(int rho) { const int n = rho >> 4, i = rho & 15; return 8 * (i >> 2) + 4 * n + (i & 3); }

struct Unit { int pm, pn; };
struct Gemm { const bf16_t* A; const bf16_t* Bt; int M, N, K, lda; };

struct StaticOrder {
    int nM, nN, nwg, G, c;
    __host__ __device__ void init(int M, int N, int G_, int c_) { nM = M / BM; nN = N / BM; nwg = nM * nN; G = G_; c = c_; }
    __host__ __device__ bool next(int i, Unit& u) const {
        const long L = (long)i * G + c; if (L >= nwg) return false;
        int wgid = (int)L; { const int q = nwg / NXCD, r = nwg % NXCD, xcd = wgid % NXCD, off = wgid / NXCD; wgid = (xcd < r ? xcd * (q + 1) : r * (q + 1) + (xcd - r) * q) + off; }
        const int nig = WGM * nN, gid = wgid / nig, fm = gid * WGM, gsz = (nM - fm) < WGM ? (nM - fm) : WGM;
        u.pm = fm + ((wgid % nig) % gsz); u.pn = (wgid % nig) / gsz; return true;
    }
    __device__ __forceinline__ void a_ready(const Unit&) const {}
    __device__ __forceinline__ void done(const Unit&) const {}
};
struct WindowOrder : StaticOrder {
    int i0, i1, rot;
    __host__ __device__ bool next(int i, Unit& u) const {
        if (i + i0 >= i1 || !StaticOrder::next(i + i0, u)) return false;
        u.pn = (u.pn + rot >= nN) ? u.pn + rot - nN : u.pn + rot; return true;
    }
};

typedef float f32x2c __attribute__((ext_vector_type(2))); typedef __bf16 bf16x2c __attribute__((ext_vector_type(2)));
__device__ __forceinline__ unsigned cvt_pk_bf16(float lo, float hi) { const f32x2c v = {lo, hi}; return __builtin_bit_cast(unsigned, __builtin_convertvector(v, bf16x2c)); }
typedef float f32x2 __attribute__((ext_vector_type(2)));
typedef unsigned u32x2 __attribute__((ext_vector_type(2)));
typedef int i32x8 __attribute__((ext_vector_type(8)));
constexpr float F8_HID = 16.0f;
constexpr float F8_HS = 24.0f;
__device__ __forceinline__ unsigned f8pk4(float a, float b, float c, float d, float s) {
    const float MG = 12582912.0f;
    const float t0 = fminf(fmaxf(fmaf(a, s, MG), MG - 127.f), MG + 127.f), t1 = fminf(fmaxf(fmaf(b, s, MG), MG - 127.f), MG + 127.f);
    const float t2 = fminf(fmaxf(fmaf(c, s, MG), MG - 127.f), MG + 127.f), t3 = fminf(fmaxf(fmaf(d, s, MG), MG - 127.f), MG + 127.f);
    return __builtin_amdgcn_perm(__float_as_uint(t1), __float_as_uint(t0), 0x0c0c0400u) | __builtin_amdgcn_perm(__float_as_uint(t3), __float_as_uint(t2), 0x04000c0cu);
}
typedef int i32x4 __attribute__((ext_vector_type(4)));
constexpr float RMS_EPS = 1e-6f;
constexpr float K_LOG2E = 1.4426950408889634f;
constexpr float K_C2 = 0.125f * 1.4426950408889634f;
__device__ __forceinline__ float row_rstd(const float* ssq, int row) {
    const f32x4* p = (const f32x4*)(ssq + (size_t)row * 16);
    const f32x4 a = p[0], b = p[1], c = p[2], d = p[3];
    const float s = (((a[0] + a[1]) + (a[2] + a[3])) + ((b[0] + b[1]) + (b[2] + b[3]))) + (((c[0] + c[1]) + (c[2] + c[3])) + ((d[0] + d[1]) + (d[2] + d[3])));
    return 1.0f / sqrtf(s * (1.0f / 1024.0f) + RMS_EPS);
}
__device__ __forceinline__ const PG8_LAS float* wave_rstd_table(PG8_LAS unsigned char* tab, const float* ssq, const Unit& u, int wr, int wc, int lane) {
    PG8_LAS float* t = (PG8_LAS float*)(tab + (wr * 4 + wc) * 1024);
    if (__builtin_amdgcn_readfirstlane(__float_as_int(t[128])) != u.pm) {
#pragma unroll
        for (int k = 0; k < 2; ++k) { const int slot = lane + 64 * k; const int row = u.pm * BM + (slot >> 6) * HALF + wr * 64 + (slot & 63); t[slot] = row_rstd(ssq, row); }
        if (lane == 0) t[128] = __int_as_float(u.pm);
        asm volatile("s_waitcnt lgkmcnt(0)" ::: "memory");
    }
    return t;
}
__device__ __forceinline__ float mul_s(float a, float b) { float r; asm("v_mul_f32_e32 %0, %1, %2" : "=v"(r) : "v"(a), "v"(b)); return r; }
struct EpiSwiGLU {
    static constexpr bool PERM = true, AFTER_DRAIN = false;
    unsigned char* H; int ldh; const float* ssq; PG8_LAS unsigned char* tab; const float* wsc;
    __device__ __forceinline__ void operator()(const f32x4 (&acc)[2][2][4][2], const Unit& u, int wr, int wc, int fr, int fq) const {
        const int row0 = u.pm * BM + wr * 64 + fr, col0 = u.pn * HALF + wc * 32 + 8 * fq;
        const float* wq = wsc + u.pn * BM + wc * 32 + 8 * fq;
        const f32x4 gs0 = *(const f32x4*)wq, gs1 = *(const f32x4*)(wq + 4), us0 = *(const f32x4*)(wq + HALF), us1 = *(const f32x4*)(wq + HALF + 4);
#define PG8_MUL(x, y) mul_s((x), (y))
        float ng[8], w8[8];
#pragma unroll
        for (int e = 0; e < 4; ++e) { ng[e] = PG8_MUL(gs0[e], -K_LOG2E); ng[4 + e] = PG8_MUL(gs1[e], -K_LOG2E); w8[e] = PG8_MUL(PG8_MUL(gs0[e], us0[e]), F8_HID); w8[4 + e] = PG8_MUL(PG8_MUL(gs1[e], us1[e]), F8_HID); }
        const PG8_LAS float* rt = wave_rstd_table(tab, ssq, u, wr, wc, fr + 16 * fq);
#pragma unroll
        for (int ai = 0; ai < 2; ++ai)
#pragma unroll
            for (int m = 0; m < 4; ++m) {
                const int row = row0 + ai * HALF + m * 16; const float rs = rt[64 * ai + 16 * m + fr] * (1.0f / F8_HS); const float rs2 = PG8_MUL(rs, rs);
                float h[8];
#pragma unroll
                for (int n = 0; n < 2; ++n)
#pragma unroll
                    for (int e = 0; e < 4; ++e) { const float a = acc[ai][0][m][n][e], b = acc[ai][1][m][n][e];
                        const float r = __builtin_amdgcn_rcpf(1.0f + __builtin_amdgcn_exp2f(PG8_MUL(PG8_MUL(a, ng[4 * n + e]), rs)));
                        h[4 * n + e] = PG8_MUL(PG8_MUL(a, b), w8[4 * n + e]) * r; }
                u32x2 w; w.x = f8pk4(h[0], h[1], h[2], h[3], rs2); w.y = f8pk4(h[4], h[5], h[6], h[7], rs2);
                *(u32x2*)(H + (size_t)row * ldh + col0) = w;
                asm volatile("" ::: "memory");
            }
#undef PG8_MUL
    }
};
template <long F8D = 0, bool CS = false> struct EpiRes {
    static constexpr bool PERM = true, AFTER_DRAIN = false;
    bf16_t* hb; float* ssq; float scale; const float* wsc;
    __device__ __forceinline__ void operator()(const f32x4 (&acc)[2][2][4][2], const Unit& u, int wr, int wc, int fr, int fq) const {
        const int col0 = u.pn * BM + wc * 32 + 8 * fq;
        f32x4 cs[2][2];
#pragma unroll
        for (int bj = 0; bj < 2; ++bj)
#pragma unroll
            for (int n = 0; n < 2; ++n) { if constexpr (CS) cs[bj][n] = *(const f32x4*)(wsc + col0 + bj * HALF + 4 * n) * scale; else cs[bj][n] = (f32x4){scale, scale, scale, scale}; }
#pragma unroll
        for (int ai = 0; ai < 2; ++ai)
#pragma unroll
            for (int m = 0; m < 4; ++m) {
                const int row = u.pm * BM + ai * HALF + wr * 64 + m * 16 + fr; const size_t off = (size_t)row * 1024 + col0;
                float ss = 0.f;
#pragma unroll
                for (int bj = 0; bj < 2; ++bj) { const u32x4 b = *(const u32x4*)(hb + off + bj * HALF);
                    const f32x4 b0 = {__uint_as_float(b.x << 16), __uint_as_float(b.x & 0xffff0000u), __uint_as_float(b.y << 16), __uint_as_float(b.y & 0xffff0000u)};
                    const f32x4 b1 = {__uint_as_float(b.z << 16), __uint_as_float(b.z & 0xffff0000u), __uint_as_float(b.w << 16), __uint_as_float(b.w & 0xffff0000u)};
                    const f32x4 o0 = b0 + acc[ai][bj][m][0] * cs[bj][0], o1 = b1 + acc[ai][bj][m][1] * cs[bj][1];
                    u32x4 w; w.x = cvt_pk_bf16(o0[0], o0[1]); w.y = cvt_pk_bf16(o0[2], o0[3]); w.z = cvt_pk_bf16(o1[0], o1[1]); w.w = cvt_pk_bf16(o1[2], o1[3]);
                    *(u32x4*)(hb + off + bj * HALF) = w;
                    if constexpr (F8D != 0) { unsigned char* hb8 = (unsigned char*)hb + F8D; u32x2 q; q.x = f8pk4(o0[0], o0[1], o0[2], o0[3], F8_HS); q.y = f8pk4(o1[0], o1[1], o1[2], o1[3], F8_HS); *(u32x2*)(hb8 + off + bj * HALF) = q; }
                    ss += ((o0[0] * o0[0] + o0[1] * o0[1]) + (o0[2] * o0[2] + o0[3] * o0[3])) + ((o1[0] * o1[0] + o1[1] * o1[1]) + (o1[2] * o1[2] + o1[3] * o1[3])); }
                ss += __shfl_xor(ss, 16); ss += __shfl_xor(ss, 32);
                if (fq == 0) ssq[(size_t)row * 16 + u.pn * 4 + wc] = ss;
                asm volatile("" ::: "memory");
            }
    }
};
struct EpiProj {
    static constexpr bool PERM = true, AFTER_DRAIN = false;
    bf16_t *ATT, *QI, *FK, *FV, *KI; float *CR, *WI, *FL; const float* ssq; PG8_LAS unsigned char* tab; const float* wsc; unsigned* nrm;
    __device__ __forceinline__ void operator()(const f32x4 (&acc)[2][2][4][2], const Unit& u, int wr, int wc, int fr, int fq) const {
        const int row0 = u.pm * BM + wr * 64 + fr, pn = u.pn, cl = wc * 32 + 8 * fq;
        const float* wq = wsc + pn * BM + cl;
        const f32x4 cs[2][2] = {{*(const f32x4*)wq, *(const f32x4*)(wq + 4)}, {*(const f32x4*)(wq + HALF), *(const f32x4*)(wq + HALF + 4)}};
        const PG8_LAS float* rt = wave_rstd_table(tab, ssq, u, wr, wc, fr + 16 * fq);
        if (pn < 10) {
            bf16_t* base; int ld, colt; float sc;
            if (pn < 2) { base = ATT; ld = 1536; colt = 512 + pn * 256; sc = K_C2; }
            else if (pn < 4) { base = QI; ld = 512; colt = (pn - 2) * 256; sc = 0.125f; }
            else if (pn < 6) { base = ATT; ld = 1536; colt = (pn - 4) * 256; sc = K_C2; }
            else if (pn < 8) { base = FK; ld = 512; colt = (pn - 6) * 256; sc = 1.0f; }
            else { base = FV; ld = 512; colt = (pn - 8) * 256; sc = 1.0f; }
            const bool fox_qk = pn >= 4 && pn < 8; float hmx[2] = {0.f, 0.f};
#pragma unroll
            for (int ai = 0; ai < 2; ++ai)
#pragma unroll
                for (int m = 0; m < 4; ++m) {
                    const int row = row0 + ai * HALF + m * 16; const float rs = rt[64 * ai + 16 * m + fr] * (sc * (1.0f / F8_HS)); bf16_t* rowp = base + (size_t)row * ld + colt + cl;
#pragma unroll
                    for (int bj = 0; bj < 2; ++bj) { const f32x4 v0 = acc[ai][bj][m][0] * (cs[bj][0] * rs), v1 = acc[ai][bj][m][1] * (cs[bj][1] * rs);
                        u32x4 w; w.x = cvt_pk_bf16(v0[0], v0[1]); w.y = cvt_pk_bf16(v0[2], v0[3]); w.z = cvt_pk_bf16(v1[0], v1[1]); w.w = cvt_pk_bf16(v1[2], v1[3]);
                        *(u32x4*)(rowp + bj * HALF) = w;
                        if (fox_qk) { float hs = ((v0[0] * v0[0] + v0[1] * v0[1]) + (v0[2] * v0[2] + v0[3] * v0[3])) + ((v1[0] * v1[0] + v1[1] * v1[1]) + (v1[2] * v1[2] + v1[3] * v1[3]));
                            hs += __shfl_xor(hs, 16); hs += __shfl_xor(hs, 32); hmx[bj] = fmaxf(hmx[bj], hs); } }
                    asm volatile("" ::: "memory");
                }
            if (fox_qk) {
#pragma unroll
                for (int bj = 0; bj < 2; ++bj) { float m_ = hmx[bj];
#pragma unroll
                    for (int o = 1; o < 16; o <<= 1) m_ = fmaxf(m_, __shfl_xor(m_, o));
                    if (fr == 0 && fq == 0) atomicMax(nrm + (((u.pm >> 4) * 8 + (pn & 1) * 4 + bj * 2 + (wc >> 1)) * 2 + (pn >= 6 ? 1 : 0)), __float_as_uint(m_)); }
            }
        } else {
#pragma unroll
            for (int ai = 0; ai < 2; ++ai)
#pragma unroll
                for (int m = 0; m < 4; ++m) {
                    const int row = row0 + ai * HALF + m * 16; const float rs = rt[64 * ai + 16 * m + fr] * (1.0f / F8_HS);
                    *(f32x4*)(CR + (size_t)row * 128 + cl) = acc[ai][0][m][0] * (cs[0][0] * rs); *(f32x4*)(CR + (size_t)row * 128 + cl + 4) = acc[ai][0][m][1] * (cs[0][1] * rs);
                    const f32x4 v0 = acc[ai][1][m][0] * (cs[1][0] * rs), v1 = acc[ai][1][m][1] * (cs[1][1] * rs);
                    if (wc < 2) { u32x4 w; w.x = cvt_pk_bf16(v0[0], v0[1]); w.y = cvt_pk_bf16(v0[2], v0[3]); w.z = cvt_pk_bf16(v1[0], v1[1]); w.w = cvt_pk_bf16(v1[2], v1[3]);
                        *(u32x4*)(KI + (size_t)row * 64 + cl) = w; }
                    else if (wc == 2) {
                        if (fq == 0) { const float s8 = 0.35355339059327373f; *(f32x4*)(WI + (size_t)row * 8) = v0 * s8; *(f32x4*)(WI + (size_t)row * 8 + 4) = v1 * s8; }
                        else if (fq == 1) { *(f32x4*)(FL + (size_t)row * 8) = v0; *(f32x4*)(FL + (size_t)row * 8 + 4) = v1; }
                    }
                    asm volatile("" ::: "memory");
                }
        }
    }
};

template <class Epi, class Sched, bool ALIGN_EPI = false, bool SP2 = false, bool F8 = false>
__device__ __forceinline__ void gemm_phase(PG8_LAS unsigned char* lds, const Gemm g, const Sched& S, const Epi& E) {
    int tid_ = threadIdx.x; asm volatile("" : "+v"(tid_));
    const int tid = tid_, wid = __builtin_amdgcn_readfirstlane(tid >> 6), lane = tid & 63, wr = wid >> 2, wc = wid & 3, fr = lane & 15, fq = lane >> 4;
    int K_ = g.K; asm volatile("" : "+s"(K_));
    const int K = K_, nt = K / BK, lda = g.lda;
    unsigned voffA[2], voffB[2];
#pragma unroll
    for (int i = 0; i < 2; ++i) { int R, C; stage_rc(tid * 16 + i * 8192, R, C); const int Rb = Epi::PERM ? ((R & ~31) + perm32(R & 31)) : R;
        voffA[i] = (unsigned)(R * lda + C) * 2u; voffB[i] = (unsigned)(Rb * K + C) * 2u; }
    const size_t kstep = (size_t)(BK * 2);
    const size_t hstep = (size_t)HALF * K * 2;
    const size_t tstep = 2 * hstep;
    const size_t hstepA = (size_t)HALF * lda * 2, tstepA = 2 * hstepA;
    const unsigned ldsw = (unsigned)wid * 1024u;
    const int aoff = lds_byte(wr * 64 + fr, fq * 8), boff = lds_byte(wc * 32 + fr, fq * 8);
#define PG8_SA(b, h) (((b) * 2 + (h)) * HTB)
#define PG8_SB(b, h) ((4 + (b) * 2 + (h)) * HTB)
#define PG8_STAGE(bufoff, gbase, voff) do { _Pragma("unroll") for (int _i = 0; _i < 2; ++_i) \
        __builtin_amdgcn_global_load_lds((const unsigned*)((const char*)(gbase) + (voff)[_i]), (PG8_LAS unsigned*)(lds + (bufoff) + ldsw + _i * 8192), 16, 0, 0); } while (0)
#define PG8_LDA(dst, b, h) do { _Pragma("unroll") for (int m = 0; m < 4; ++m) _Pragma("unroll") for (int k = 0; k < 2; ++k) dst[m][k] = *(const PG8_LAS bf16x8*)(lds + PG8_SA(b, h) + aoff + m * 2048 + k * 1024); } while (0)
#define PG8_LDB(dst, b, h) do { _Pragma("unroll") for (int n = 0; n < 2; ++n) _Pragma("unroll") for (int k = 0; k < 2; ++k) dst[n][k] = *(const PG8_LAS bf16x8*)(lds + PG8_SB(b, h) + boff + n * 2048 + k * 1024); } while (0)
#define PG8_MMA(ai, bj, At, Bt) do { __builtin_amdgcn_s_setprio(1); _Pragma("unroll") for (int m = 0; m < 4; ++m) _Pragma("unroll") for (int n = 0; n < 2; ++n) _Pragma("unroll") for (int k = 0; k < 2; ++k) { \
        if constexpr (F8) acci[ai][bj][m][n] = __builtin_amdgcn_mfma_i32_16x16x64_i8(__builtin_bit_cast(i32x4, Bt[n][k]), __builtin_bit_cast(i32x4, At[m][k]), acci[ai][bj][m][n], 0, 0, 0); \
        else acc[ai][bj][m][n] = __builtin_amdgcn_mfma_f32_16x16x32_bf16(Bt[n][k], At[m][k], acc[ai][bj][m][n], 0, 0, 0); } \
        __builtin_amdgcn_s_setprio(0); } while (0)
#define PG8_WAIT_V(n) asm volatile("s_waitcnt vmcnt(" #n ")" ::: "memory")
#define PG8_WAIT_L(n) asm volatile("s_waitcnt lgkmcnt(" #n ")" ::: "memory")
#define PG8_BAR __builtin_amdgcn_s_barrier()
#define PG8_SCHED __builtin_amdgcn_sched_barrier(0)
    Unit cur, nxt; int ui = 0;
    if (!S.next(0, cur)) return;
    f32x4 acc[2][2][4][2]; i32x4 acci[2][2][4][2];
#pragma unroll
    for (int a = 0; a < 2; ++a)
#pragma unroll
        for (int b = 0; b < 2; ++b)
#pragma unroll
            for (int m = 0; m < 4; ++m)
#pragma unroll
                for (int n = 0; n < 2; ++n) { if constexpr (F8) acci[a][b][m][n] = (i32x4){0, 0, 0, 0}; else acc[a][b][m][n] = (f32x4){0.f, 0.f, 0.f, 0.f}; }
    bf16x8 At[4][2], B0[2][2], B1[2][2];
    const char* cA = (const char*)g.A + (size_t)cur.pm * tstepA; const char* cB = (const char*)g.Bt + (size_t)cur.pn * tstep;
    S.a_ready(cur);
    if constexpr (SP2) {
        PG8_STAGE(PG8_SB(0, 0), cB, voffB); PG8_STAGE(PG8_SB(0, 1), cB + hstep, voffB); PG8_STAGE(PG8_SA(0, 0), cA, voffA); PG8_STAGE(PG8_SA(0, 1), cA + hstepA, voffA);
        if (wr == 1) PG8_BAR;
        PG8_WAIT_V(2); PG8_BAR;
        PG8_STAGE(PG8_SB(1, 0), cB + kstep, voffB); PG8_STAGE(PG8_SA(1, 0), cA + kstep, voffA); PG8_STAGE(PG8_SB(1, 1), cB + hstep + kstep, voffB);
        PG8_WAIT_V(6); PG8_BAR;
    } else {
        PG8_STAGE(PG8_SB(0, 0), cB, voffB); PG8_STAGE(PG8_SA(0, 0), cA, voffA); PG8_STAGE(PG8_SB(0, 1), cB + hstep, voffB); PG8_STAGE(PG8_SA(0, 1), cA + hstepA, voffA);
        if (wr == 1) PG8_BAR;
        PG8_WAIT_V(4); PG8_BAR;
        PG8_STAGE(PG8_SB(1, 0), cB + kstep, voffB); PG8_STAGE(PG8_SA(1, 0), cA + kstep, voffA); PG8_STAGE(PG8_SB(1, 1), cB + hstep + kstep, voffB);
        PG8_WAIT_V(6); PG8_BAR;
    }
    for (;;) {
        const bool has_next = S.next(ui + 1, nxt);
        const char* nA = has_next ? (const char*)g.A + (size_t)nxt.pm * tstepA : cA; const char* nB = has_next ? (const char*)g.Bt + (size_t)nxt.pn * tstep : cB;
#pragma unroll 1
        for (int t = 0; t < nt; t += 2) {
            const bool last = (t == nt - 2);
            const char* a1 = cA + (size_t)(t + 1) * kstep;
            const char* a2 = last ? nA : cA + (size_t)(t + 2) * kstep; const char* b2 = last ? nB : cB + (size_t)(t + 2) * kstep;
            const char* a3 = a2 + kstep; const char* b3 = b2 + kstep;
            if (last && has_next) S.a_ready(nxt);
            if constexpr (SP2) {
            PG8_LDB(B0, 0, 0); PG8_LDB(B1, 0, 1); PG8_SCHED; PG8_LDA(At, 0, 0); PG8_STAGE(PG8_SA(1, 1), a1 + hstepA, voffA);
            PG8_WAIT_V(8); PG8_WAIT_L(0); PG8_BAR; PG8_MMA(0, 0, At, B0); PG8_MMA(0, 1, At, B1); PG8_BAR; PG8_SCHED;
            PG8_LDA(At, 0, 1); PG8_STAGE(PG8_SB(0, 0), b2, voffB); PG8_STAGE(PG8_SB(0, 1), b2 + hstep, voffB); PG8_STAGE(PG8_SA(0, 0), a2, voffA);
            PG8_WAIT_V(8); PG8_WAIT_L(0); PG8_BAR; PG8_MMA(1, 0, At, B0); PG8_MMA(1, 1, At, B1); PG8_BAR; PG8_SCHED;
            PG8_LDB(B0, 1, 0); PG8_LDB(B1, 1, 1); PG8_SCHED; PG8_LDA(At, 1, 0); PG8_STAGE(PG8_SA(0, 1), a2 + hstepA, voffA);
            PG8_WAIT_V(8); PG8_WAIT_L(0); PG8_BAR; PG8_MMA(0, 0, At, B0); PG8_MMA(0, 1, At, B1); PG8_BAR; PG8_SCHED;
            PG8_LDA(At, 1, 1); PG8_STAGE(PG8_SB(1, 0), b3, voffB); PG8_STAGE(PG8_SB(1, 1), b3 + hstep, voffB); PG8_STAGE(PG8_SA(1, 0), a3, voffA);
            PG8_WAIT_V(8); PG8_WAIT_L(0); PG8_BAR; PG8_MMA(1, 0, At, B0); PG8_MMA(1, 1, At, B1); PG8_BAR; PG8_SCHED;
            } else {
            PG8_LDB(B0, 0, 0); PG8_SCHED; PG8_LDA(At, 0, 0); PG8_STAGE(PG8_SA(1, 1), a1 + hstepA, voffA);
            PG8_WAIT_L(8); PG8_BAR; PG8_WAIT_L(0); PG8_MMA(0, 0, At, B0); PG8_BAR; PG8_SCHED;
            PG8_LDB(B1, 0, 1); PG8_STAGE(PG8_SB(0, 0), b2, voffB);
            PG8_BAR; PG8_WAIT_L(0); PG8_MMA(0, 1, At, B1); PG8_BAR;
            PG8_LDA(At, 0, 1); PG8_STAGE(PG8_SA(0, 0), a2, voffA);
            PG8_BAR; PG8_WAIT_L(0); PG8_MMA(1, 0, At, B0); PG8_BAR; PG8_SCHED;
            PG8_STAGE(PG8_SB(0, 1), b2 + hstep, voffB);
            PG8_WAIT_V(6); PG8_BAR; PG8_MMA(1, 1, At, B1); PG8_BAR;
            PG8_LDB(B0, 1, 0); PG8_SCHED; PG8_LDA(At, 1, 0); PG8_STAGE(PG8_SA(0, 1), a2 + hstepA, voffA);
            PG8_WAIT_L(8); PG8_BAR; PG8_WAIT_L(0); PG8_MMA(0, 0, At, B0); PG8_BAR; PG8_SCHED;
            PG8_LDB(B1, 1, 1); PG8_STAGE(PG8_SB(1, 0), b3, voffB);
            PG8_BAR; PG8_WAIT_L(0); PG8_MMA(0, 1, At, B1); PG8_BAR;
            PG8_LDA(At, 1, 1); PG8_STAGE(PG8_SA(1, 0), a3, voffA);
            PG8_BAR; PG8_WAIT_L(0); PG8_MMA(1, 0, At, B0); PG8_BAR; PG8_SCHED;
            PG8_STAGE(PG8_SB(1, 1), b3 + hstep, voffB);
            PG8_WAIT_V(6); PG8_BAR; PG8_MMA(1, 1, At, B1); PG8_BAR;
            }
        }
        if constexpr (ALIGN_EPI) { if (wr == 0) PG8_BAR; }
        if constexpr (F8) {
#pragma unroll
            for (int a = 0; a < 2; ++a)
#pragma unroll
                for (int b = 0; b < 2; ++b)
#pragma unroll
                    for (int m = 0; m < 4; ++m)
#pragma unroll
                        for (int n = 0; n < 2; ++n) acc[a][b][m][n] = __builtin_convertvector(acci[a][b][m][n], f32x4);
        }
        if constexpr (!Epi::AFTER_DRAIN) { E(acc, cur, wr, wc, fr, fq); S.done(cur); }
        if (!has_next) break;
#pragma unroll
        for (int a = 0; a < 2; ++a)
#pragma unroll
            for (int b = 0; b < 2; ++b)
#pragma unroll
                for (int m = 0; m < 4; ++m)
#pragma unroll
                    for (int n = 0; n < 2; ++n) { if constexpr (F8) acci[a][b][m][n] = (i32x4){0, 0, 0, 0}; else acc[a][b][m][n] = (f32x4){0.f, 0.f, 0.f, 0.f}; }
        cur = nxt; cA = nA; cB = nB; ++ui;
        if constexpr (ALIGN_EPI) { if (wr == 1) PG8_BAR; }
    }
    PG8_WAIT_V(0);
    if constexpr (!ALIGN_EPI) { if (wr == 0) PG8_BAR; }
    PG8_BAR;
    if constexpr (Epi::AFTER_DRAIN) { E.fused(acc, cur, wr, wc, fr, fq, lds, wid, lane); S.done(cur); }
#undef PG8_SA
#undef PG8_SB
#undef PG8_STAGE
#undef PG8_LDA
#undef PG8_LDB
#undef PG8_MMA
#undef PG8_WAIT_V
#undef PG8_WAIT_L
#undef PG8_BAR
#undef PG8_SCHED
}
}
namespace attn_body {
using bf16=__hip_bfloat16;
using bf16x8=__attribute__((ext_vector_type(8)))short;
using s16x4=__attribute__((ext_vector_type(4)))short;
using f32x16=__attribute__((ext_vector_type(16)))float;
using u32x4=__attribute__((ext_vector_type(4)))unsigned;
using f32x4v=__attribute__((ext_vector_type(4)))float;
constexpr int BATCH=8,NHEAD=8,SEQ=4096,D=64,QP=1536,KP=512;
constexpr int NW=8,QBLK=32,QB=QBLK*NW,KVBLK=64,NQB=SEQ/QB;
constexpr int ATTN_UNIT_ROWS=QB;
__device__ __forceinline__ int crow(int r,int hi){return (r&3)+8*(r>>2)+4*hi;}
#define SBAR() __builtin_amdgcn_sched_barrier(0)
__device__ __forceinline__ void cmask(f32x16&p0,f32x16&p1,int jb,int qrel,int hi){
  const float NEG=-INFINITY; int kb=64*jb+4*hi;
  #pragma unroll
  for(int r=0;r<16;++r){int kv=kb+(r&3)+8*(r>>2); if(kv>qrel)p0[r]=NEG; if(kv+32>qrel)p1[r]=NEG;}
}

constexpr int NSLOT=3, SLOTB=8192;
constexpr int LDS_K=0, LDS_V=NSLOT*SLOTB, LDS_WS=2*NSLOT*SLOTB, LDS_OST=LDS_WS+NW*64*4, LDS_BIAS=LDS_OST+NW*4096, LDS_BYTES=LDS_BIAS+SEQ*4;
constexpr float C2=0.125f*1.4426950408889634f;
__device__ __forceinline__ void glds16(const void*gsrc,unsigned lds_dst){unsigned keep;
  asm volatile("s_mov_b32 %0, m0\n\ts_mov_b32 m0, %2\n\ts_nop 0\n\tglobal_load_lds_dwordx4 %1, off\n\ts_mov_b32 m0, %0":"=&s"(keep):"v"(gsrc),"s"(lds_dst):"memory");}
__device__ __forceinline__ float max3f(float a,float b,float c){float r;asm("v_max3_f32 %0, %1, %2, %3":"=v"(r):"v"(a),"v"(b),"v"(c));return r;}
__device__ __forceinline__ float max2f(float a,float b){float r;asm("v_max_f32_e32 %0, %1, %2":"=v"(r):"v"(a),"v"(b));return r;}
__device__ __forceinline__ float fadd_s(float a,float b){float r;asm("v_add_f32_e32 %0, %1, %2":"=v"(r):"v"(a),"v"(b));return r;}
__device__ __forceinline__ float fsub_s(float a,float b){float r;asm("v_sub_f32_e32 %0, %1, %2":"=v"(r):"v"(a),"v"(b));return r;}
typedef float f32x2_t __attribute__((ext_vector_type(2))); typedef __bf16 bf16x2_t __attribute__((ext_vector_type(2)));
__device__ __forceinline__ unsigned cvtpk_s(float lo,float hi){f32x2_t v={lo,hi};bf16x2_t b=__builtin_convertvector(v,bf16x2_t);return __builtin_bit_cast(unsigned,b);}
#define WAIT_BAR(N) asm volatile("s_waitcnt vmcnt(" #N ") lgkmcnt(0)\n\ts_barrier":::"memory")

__device__ __forceinline__ void qkt(f32x16&p0,f32x16&p1,const char*Kslot,const bf16x8*qr,int r32,int hi){
  const char*kb=Kslot+hi*1024+r32*16;
  #pragma unroll
  for(int d0=0;d0<4;++d0){
    const bf16x8 b0=*reinterpret_cast<const bf16x8*>(kb+d0*2048);
    const bf16x8 b1=*reinterpret_cast<const bf16x8*>(kb+d0*2048+512);
    p0=__builtin_amdgcn_mfma_f32_32x32x16_bf16(b0,qr[d0],p0,0,0,0);p1=__builtin_amdgcn_mfma_f32_32x32x16_bf16(b1,qr[d0],p1,0,0,0);}
}
typedef __attribute__((address_space(3))) const char* lds_cptr;
typedef short v4i16_t __attribute__((ext_vector_type(4)));
__device__ __forceinline__ void kload8(bf16x8*kf,lds_cptr kp){
  kf[0]=*(const __attribute__((address_space(3))) bf16x8*)(kp);      kf[1]=*(const __attribute__((address_space(3))) bf16x8*)(kp+512);
  kf[2]=*(const __attribute__((address_space(3))) bf16x8*)(kp+2048); kf[3]=*(const __attribute__((address_space(3))) bf16x8*)(kp+2560);
  kf[4]=*(const __attribute__((address_space(3))) bf16x8*)(kp+4096); kf[5]=*(const __attribute__((address_space(3))) bf16x8*)(kp+4608);
  kf[6]=*(const __attribute__((address_space(3))) bf16x8*)(kp+6144); kf[7]=*(const __attribute__((address_space(3))) bf16x8*)(kp+6656);
}
__device__ __forceinline__ void kload2(bf16x8*kf,lds_cptr kp,int j){ kf[2*j]=*(const __attribute__((address_space(3))) bf16x8*)(kp+j*2048); kf[2*j+1]=*(const __attribute__((address_space(3))) bf16x8*)(kp+j*2048+512); }
__device__ __forceinline__ s16x4 vtr(lds_cptr p){ return __builtin_bit_cast(s16x4,__builtin_amdgcn_ds_read_tr16_b64_v4i16((__attribute__((address_space(3))) v4i16_t*)p)); }
__device__ __forceinline__ float rowmax(const f32x16&p0,const f32x16&p1){
  float a=max3f(p0[0],p0[1],p1[0]),b=max3f(p0[2],p0[3],p1[1]);a=max3f(a,p1[2],p1[3]);
  #pragma unroll
  for(int r=4;r<16;r+=4){a=max3f(a,p0[r],p0[r+1]);b=max3f(b,p0[r+2],p0[r+3]);a=max3f(a,p1[r],p1[r+1]);b=max3f(b,p1[r+2],p1[r+3]);}
  const float m=max2f(a,b);
  auto rr=__builtin_amdgcn_permlane32_swap(__float_as_uint(m),__float_as_uint(m),false,false);
  return max2f(__uint_as_float(rr[0]),__uint_as_float(rr[1]));
}
__device__ __forceinline__ void pv(f32x16*o,int vb,bf16x8 pa0,bf16x8 pa1,bf16x8 pa2,bf16x8 pa3){
  #pragma unroll
  for(int d0=0;d0<2;++d0){s16x4 lo[4],hi[4];
    #pragma unroll
    for(int ks=0;ks<4;++ks){
      asm volatile("ds_read_b64_tr_b16 %0,%1 offset:%c2":"=&v"(lo[ks]):"v"(vb),"i"(d0*4096+ks*1024):"memory");
      asm volatile("ds_read_b64_tr_b16 %0,%1 offset:%c2":"=&v"(hi[ks]):"v"(vb),"i"(d0*4096+ks*1024+512):"memory");}
    asm volatile("s_waitcnt lgkmcnt(0)":::"memory");SBAR();
    #define PK(k) (bf16x8){lo[k][0],lo[k][1],lo[k][2],lo[k][3],hi[k][0],hi[k][1],hi[k][2],hi[k][3]}
    o[d0]=__builtin_amdgcn_mfma_f32_32x32x16_bf16(pa0,PK(0),o[d0],0,0,0);
    o[d0]=__builtin_amdgcn_mfma_f32_32x32x16_bf16(pa1,PK(1),o[d0],0,0,0);
    o[d0]=__builtin_amdgcn_mfma_f32_32x32x16_bf16(pa2,PK(2),o[d0],0,0,0);
    o[d0]=__builtin_amdgcn_mfma_f32_32x32x16_bf16(pa3,PK(3),o[d0],0,0,0);
    #undef PK
  }
}

#ifndef ATTN_STORE16
#define ATTN_STORE16(p,v) (*(u32x4*)(p)=(v))
#endif
template<int THRL> __device__ __forceinline__ void attn_unit(int b,int h,int qb,const bf16*Q,const bf16*__restrict__ K,const bf16*__restrict__ V,bf16*O,const float*__restrict__ nbias,char*shm,int dry,float Tb){
  int tid_=threadIdx.x; asm volatile("":"+v"(tid_)); const int tid=tid_,lane=tid&63,r32=lane&31,hi=lane>>5; const int wid=__builtin_amdgcn_readfirstlane(tid>>6);
  const long rowbase=(long)b*SEQ; const int q0=qb*QB;
  int ts=0;
  { typedef __attribute__((address_space(3))) float* lfp; const lfp bl=(lfp)((__attribute__((address_space(3))) char*)shm+LDS_BIAS);
    const float thr=nbias[q0]-Tb; int cnt=0;
    for(int i=tid*4;i<q0+QB;i+=NW*64*4){ const f32x4v v=*reinterpret_cast<const f32x4v*>(nbias+i); *(__attribute__((address_space(3))) f32x4v*)(bl+i)=v;
      cnt+=(v[0]<thr?1:0)+(v[1]<thr?1:0)+(v[2]<thr?1:0)+(v[3]<thr?1:0); }
    #pragma unroll
    for(int o=1;o<64;o<<=1)cnt+=__shfl_xor(cnt,o);
    __attribute__((address_space(3))) int* cw=(__attribute__((address_space(3))) int*)((__attribute__((address_space(3))) char*)shm+LDS_WS);
    if(lane==0)cw[wid*64]=cnt;
    asm volatile("s_waitcnt lgkmcnt(0)\n\ts_barrier":::"memory");
    int tot=0;
    #pragma unroll
    for(int w=0;w<NW;++w)tot+=cw[w*64];
    tot=__builtin_amdgcn_readfirstlane(tot);
    ts=(tot>>6)&~1; const int tmax=(q0+QB)/KVBLK-4; ts=ts<tmax?ts:tmax; ts=ts<0?0:ts;
    asm volatile("s_waitcnt lgkmcnt(0)\n\ts_barrier":::"memory"); }
  const bf16*Qw=Q+(rowbase+q0+wid*QBLK)*QP+h*D;
  const bf16*Kh=K+(rowbase+(long)ts*KVBLK)*KP+h*D,*Vh=V+(rowbase+(long)ts*KVBLK)*KP+h*D;
  const unsigned lds0=(unsigned)(uintptr_t)shm;
  float*wsf=(float*)(shm+LDS_WS)+wid*64;
  const bf16*ksrc=Kh+(long)lane*KP+wid*8;
  const bf16*vsrc=Vh+(long)(16*(wid&3)+(lane>>2))*KP+(wid>>2)*32+(lane&3)*8;
  const unsigned kdst=lds0+LDS_K+wid*1024, vdst=lds0+LDS_V+wid*1024;
  #define DMA_K(t,slot) glds16(ksrc+(long)(t)*KVBLK*KP,(unsigned)__builtin_amdgcn_readfirstlane(kdst+(slot)))
  #define DMA_V(t,slot) glds16(vsrc+(long)(t)*KVBLK*KP,(unsigned)__builtin_amdgcn_readfirstlane(vdst+(slot)))
  const int vb0=(int)(lds0+LDS_V)+((lane>>4)&1)*32+(lane&3)*8+(4*hi+((lane&15)>>2))*64;
  const char*Kbase=shm+LDS_K; bf16x8 kf[8];
  const lds_cptr shm3=(lds_cptr)shm; const lds_cptr kp0=shm3+LDS_K+hi*1024+r32*16; const lds_cptr vp0=shm3+LDS_V+((lane>>4)&1)*32+(lane&3)*8+(4*hi+((lane&15)>>2))*64;
  const int NT=(q0+QB)/KVBLK-ts;
  DMA_K(0,0);DMA_V(0,0);DMA_K(1,SLOTB);
  bf16x8 qr[4];
  #pragma unroll
  for(int d0=0;d0<4;++d0)qr[d0]=*reinterpret_cast<const bf16x8*>(&Qw[(long)r32*QP+d0*16+hi*8]);
  float mhat=0.f,l_reg=0.f;f32x16 o[2];o[0]=f32x16{};o[1]=f32x16{};
  const int qrel=wid*QBLK+r32;
  #define CMASK(P0,P1,t) do{int jb_=(t)-(NT-4); if(jb_>=0)cmask(P0,P1,jb_,qrel,hi);}while(0)
  const __attribute__((address_space(3))) f32x4v* bias4=(const __attribute__((address_space(3))) f32x4v*)((__attribute__((address_space(3))) char*)shm+LDS_BIAS)+hi+16*ts;
  #define INITC(P0,P1,t) do{ _Pragma("unroll") for(int a_=0;a_<4;++a_){ const f32x4v v0_=bias4[16*(t)+2*a_], v1_=bias4[16*(t)+8+2*a_]; \
      _Pragma("unroll") for(int b_=0;b_<4;++b_){ P0[4*a_+b_]=v0_[b_]-mhat; P1[4*a_+b_]=v1_[b_]-mhat; } } }while(0)
  bool resc=false;
  #define START(P0,P1) do{ const float rm=rowmax(P0,P1); resc=false; \
    { const float dl=rm; mhat=fadd_s(mhat,dl); \
      _Pragma("unroll") for(int r=0;r<16;++r){P0[r]=fsub_s(P0[r],dl);P1[r]=fsub_s(P1[r],dl);} \
      } \
    _Pragma("unroll") for(int r=0;r<16;++r)P0[r]=__builtin_amdgcn_exp2f(P0[r]); }while(0)
  #define RESC() do{ if(resc){ asm volatile("s_waitcnt lgkmcnt(0)":::"memory"); \
      _Pragma("unroll") for(int d_=0;d_<2;++d_) _Pragma("unroll") for(int r=0;r<16;++r)o[d_][r]*=wsf[crow(r,hi)]; } }while(0)
  f32x16 pA0,pA1,pB0,pB1;
  int sl_prev=0,sl_cur=0,sl_next=SLOTB;
  #define ROT() do{sl_prev=sl_cur;sl_cur=sl_next;sl_next=(sl_next==(NSLOT-1)*SLOTB)?0:sl_next+SLOTB;}while(0)
  DMA_K(2,2*SLOTB);
  WAIT_BAR(3);
  INITC(pA0,pA1,0);qkt(pA0,pA1,Kbase,qr,r32,hi);asm volatile("s_nop 15\n\ts_nop 7":"+v"(pA0),"+v"(pA1));CMASK(pA0,pA1,0);
  START(pA0,pA1);
  _Pragma("unroll") for(int r=0;r<16;++r)pA1[r]=__builtin_amdgcn_exp2f(pA1[r]);
  WAIT_BAR(0);
  DMA_K(3,0);DMA_V(1,SLOTB);
  ROT();
  kload8(kf,kp0+sl_cur);
  WAIT_BAR(2);
  s16x4 vlo[8],vhi[8]; u32x4 pw0,pw1,pw2,pw3;
  #define PKW(P,B) cvtpk_s(P[B],P[B+1])
  #define PAF(k) __builtin_bit_cast(bf16x8,pw##k)
  #define VFR(i) (bf16x8){vlo[i][0],vlo[i][1],vlo[i][2],vlo[i][3],vhi[i][0],vhi[i][1],vhi[i][2],vhi[i][3]}
  #define PIN(x) asm volatile("":"+v"(x))
  #define MX3(a,b,c) __builtin_fmaxf(__builtin_fmaxf((a),(b)),(c))
  #define GAPA(MF,A0,A1,A2,A3,W0,W1,PW) do{ MF; sacc+=A0; sacc+=A1; sacc+=A2; sacc+=A3; PIN(sacc); W0; W1; PIN(PW); SBAR(); }while(0)
  #define EX(v) __builtin_amdgcn_exp2f(v)
  #define GAPB(MF,X,B) do{ MF; X[B]=EX(X[B]); X[B+1]=EX(X[B+1]); X[B+2]=EX(X[B+2]); X[B+3]=EX(X[B+3]); PIN(X); SBAR(); }while(0)
  #define VRD(i) do{ vlo[i]=vtr(vp_+(((i)>>2)*4096+((i)&3)*1024)); vhi[i]=vtr(vp_+(((i)>>2)*4096+((i)&3)*1024+512)); }while(0)
  #define KRD(G,j) do{ if(G){ kload2(kf,kp0+sl_next,j); SBAR(); } }while(0)
  #define STEP(C0,C1,P0,P1,t,GK,GV,GL) do{ SBAR(); INITC(C0,C1,t); SBAR(); \
    const lds_cptr vp_=vp0+sl_prev; \
    VRD(0); SBAR(); float sacc=(P0[0]+P0[1]); \
    GAPA(C0=__builtin_amdgcn_mfma_f32_32x32x16_bf16(kf[0],qr[0],C0,0,0,0), P0[2],P0[3],P0[4],P0[5],     pw0[0]=PKW(P0,0), pw0[1]=PKW(P0,2), pw0); \
    VRD(4); SBAR(); GAPA(C1=__builtin_amdgcn_mfma_f32_32x32x16_bf16(kf[1],qr[0],C1,0,0,0), P0[6],P0[7],P0[8],P0[9],     pw0[2]=PKW(P0,4), pw0[3]=PKW(P0,6), pw0); \
    VRD(1); SBAR(); GAPA(C0=__builtin_amdgcn_mfma_f32_32x32x16_bf16(kf[2],qr[1],C0,0,0,0),   P0[10],P0[11],P0[12],P0[13], pw1[0]=PKW(P0,8), pw1[1]=PKW(P0,10), pw1); \
    VRD(5); SBAR(); GAPA(C1=__builtin_amdgcn_mfma_f32_32x32x16_bf16(kf[3],qr[1],C1,0,0,0),   P0[14],P0[15],P1[0],P1[1],   pw1[2]=PKW(P0,12),pw1[3]=PKW(P0,14), pw1); \
    VRD(2); SBAR(); GAPA(C0=__builtin_amdgcn_mfma_f32_32x32x16_bf16(kf[4],qr[2],C0,0,0,0),   P1[2],P1[3],P1[4],P1[5],     pw2[0]=PKW(P1,0), pw2[1]=PKW(P1,2), pw2); \
    VRD(6); SBAR(); GAPA(C1=__builtin_amdgcn_mfma_f32_32x32x16_bf16(kf[5],qr[2],C1,0,0,0),   P1[6],P1[7],P1[8],P1[9],     pw2[2]=PKW(P1,4), pw2[3]=PKW(P1,6), pw2); \
    VRD(3); SBAR(); GAPA(C0=__builtin_amdgcn_mfma_f32_32x32x16_bf16(kf[6],qr[3],C0,0,0,0),   P1[10],P1[11],P1[12],P1[13], pw3[0]=PKW(P1,8), pw3[1]=PKW(P1,10), pw3); \
    VRD(7); SBAR(); GAPA(C1=__builtin_amdgcn_mfma_f32_32x32x16_bf16(kf[7],qr[3],C1,0,0,0),   P1[14],P1[15],0.f,0.f,       pw3[2]=PKW(P1,12),pw3[3]=PKW(P1,14), pw3); \
    l_reg+=sacc; \
    if(GK){DMA_K((t)+3,sl_cur);} if(GV){DMA_V((t)+1,sl_next);} \
    CMASK(C0,C1,t); \
    { float a=MX3(C0[0],C0[1],C1[0]),b=MX3(C0[2],C0[3],C1[1]); a=MX3(a,C1[2],C1[3]); \
      _Pragma("unroll") for(int r=4;r<16;r+=4){a=MX3(a,C0[r],C0[r+1]);b=MX3(b,C0[r+2],C0[r+3]);a=MX3(a,C1[r],C1[r+1]);b=MX3(b,C1[r+2],C1[r+3]);} \
      float rm=__builtin_fmaxf(a,b); { auto rr=__builtin_amdgcn_permlane32_swap(__float_as_uint(rm),__float_as_uint(rm),false,false); rm=__builtin_fmaxf(__uint_as_float(rr[0]),__uint_as_float(rr[1])); } \
      resc=false; \
      if(__builtin_expect(__any(rm>(float)THRL),0)){ const float dl=__builtin_fmaxf(rm,0.f); mhat+=dl; \
        _Pragma("unroll") for(int r=0;r<16;++r){C0[r]-=dl;C1[r]-=dl;} \
        const float f=__builtin_amdgcn_exp2f(-dl); l_reg*=f; if(hi==0)wsf[r32]=f; resc=true; } } \
    SBAR(); \
    GAPB(o[0]=__builtin_amdgcn_mfma_f32_32x32x16_bf16(PAF(0),VFR(0),o[0],0,0,0), C0,0); \
    GAPB(o[1]=__builtin_amdgcn_mfma_f32_32x32x16_bf16(PAF(0),VFR(4),o[1],0,0,0), C0,4); \
    KRD(GL,0); GAPB(o[0]=__builtin_amdgcn_mfma_f32_32x32x16_bf16(PAF(1),VFR(1),o[0],0,0,0), C0,8); \
    KRD(GL,1); GAPB(o[1]=__builtin_amdgcn_mfma_f32_32x32x16_bf16(PAF(1),VFR(5),o[1],0,0,0), C0,12); \
    KRD(GL,2); GAPB(o[0]=__builtin_amdgcn_mfma_f32_32x32x16_bf16(PAF(2),VFR(2),o[0],0,0,0), C1,0); \
    KRD(GL,3); GAPB(o[1]=__builtin_amdgcn_mfma_f32_32x32x16_bf16(PAF(2),VFR(6),o[1],0,0,0), C1,4); \
    GAPB(o[0]=__builtin_amdgcn_mfma_f32_32x32x16_bf16(PAF(3),VFR(3),o[0],0,0,0), C1,8); \
    GAPB(o[1]=__builtin_amdgcn_mfma_f32_32x32x16_bf16(PAF(3),VFR(7),o[1],0,0,0), C1,12); \
    }while(0)
  int t=1;
  #undef CMASK
  #define CMASK(P0,P1,t) do{}while(0)
  for(;t+5<NT;t+=2){
    STEP(pB0,pB1,pA0,pA1,t,true,true,true);     WAIT_BAR(2); RESC(); ROT();
    STEP(pA0,pA1,pB0,pB1,t+1,true,true,true);   WAIT_BAR(2); RESC(); ROT();
  }
  #undef CMASK
  #define CMASK(P0,P1,t) do{int jb_=(t)-(NT-4); if(jb_>=0)cmask(P0,P1,jb_,qrel,hi);}while(0)
  #define ENDW(tt) do{ if((tt)+3<NT){WAIT_BAR(2);} else if((tt)+2<NT){WAIT_BAR(1);} else {WAIT_BAR(0);} }while(0)
  for(;t+1<NT;t+=2){
    STEP(pB0,pB1,pA0,pA1,t,(t+3<NT),(t+1<NT),(t+1<NT));       ENDW(t);   RESC(); ROT();
    STEP(pA0,pA1,pB0,pB1,t+1,(t+4<NT),(t+2<NT),(t+2<NT));     ENDW(t+1); RESC(); ROT();
  }
  STEP(pB0,pB1,pA0,pA1,NT-1,false,false,false); RESC();
  { float sacc=pB0[0]+pB0[1]; _Pragma("unroll") for(int r=2;r<16;++r)sacc+=pB0[r]; _Pragma("unroll") for(int r=0;r<16;++r)sacc+=pB1[r]; l_reg+=sacc;
    pw0=(u32x4){PKW(pB0,0),PKW(pB0,2),PKW(pB0,4),PKW(pB0,6)};pw1=(u32x4){PKW(pB0,8),PKW(pB0,10),PKW(pB0,12),PKW(pB0,14)};pw2=(u32x4){PKW(pB1,0),PKW(pB1,2),PKW(pB1,4),PKW(pB1,6)};pw3=(u32x4){PKW(pB1,8),PKW(pB1,10),PKW(pB1,12),PKW(pB1,14)};
    SBAR(); pv(o,vb0+sl_cur,PAF(0),PAF(1),PAF(2),PAF(3)); }
  #undef PKW
  #undef PAF
  #undef VFR
  #undef PIN
  #undef MX3
  #undef GAPA
  #undef GAPB
  #undef EX
  #undef VRD
  #undef KRD
  #undef STEP
  #undef ENDW
  {auto rr=__builtin_amdgcn_permlane32_swap(__float_as_uint(l_reg),__float_as_uint(l_reg),false,false);l_reg=__uint_as_float(rr[0])+__uint_as_float(rr[1]);}
  if(hi==0)wsf[32+r32]=l_reg;asm volatile("s_waitcnt lgkmcnt(0)":::"memory");
  float rli[16];
  #pragma unroll
  for(int r=0;r<16;++r)rli[r]=__builtin_amdgcn_rcpf(wsf[32+crow(r,hi)]);
  bf16*Ow=O+(rowbase+q0+wid*QBLK)*QP+h*D;
  { bf16*stg=(bf16*)(shm+LDS_OST)+wid*2048;
    #pragma unroll
    for(int r=0;r<16;++r){const int orow=crow(r,hi);
      #pragma unroll
      for(int d0=0;d0<2;++d0)stg[orow*64+d0*32+r32]=__float2bfloat16(o[d0][r]*rli[r]);}
    asm volatile("s_waitcnt lgkmcnt(0)":::"memory");
    #pragma unroll
    for(int i=0;i<4;++i){const int row=i*8+(lane>>3),ch=lane&7; const u32x4 v=*(const u32x4*)(stg+row*64+ch*8); if(!dry){ATTN_STORE16(Ow+(long)row*QP+ch*8,v);}} }
  asm volatile("s_waitcnt lgkmcnt(0)\n\ts_barrier":::"memory");
  #undef DMA_K
  #undef DMA_V
  #undef CMASK
  #undef INITC
  #undef START
  #undef RESC
  #undef ROT
}
constexpr int ATTN_LDS_BYTES=LDS_BYTES;
struct AttnTensors { const bf16* Q; const bf16* K; const bf16* V; bf16* O; const float* nbias; const unsigned* nrm; };
template<int THRL=8> __device__ __forceinline__ void attn_phase(char*lds,const AttnTensors&T,int vcu,int G,int dry=0){
  for(int v=vcu;v<256;v+=G){ const int s=v&3,bh=v>>2;
    const float mq=__uint_as_float(__hip_atomic_load(T.nrm+2*bh,__ATOMIC_RELAXED,__HIP_MEMORY_SCOPE_AGENT)), mk=__uint_as_float(__hip_atomic_load(T.nrm+2*bh+1,__ATOMIC_RELAXED,__HIP_MEMORY_SCOPE_AGENT));
    const float Tb=44.0f+2.0f*(2.04f*sqrtf(mq*mk))+1.0f;
    for(int i=0;i<4;++i){ const int qb=(i==0)?s:(i==1)?7-s:(i==2)?8+s:15-s;
      attn_unit<THRL>(bh/NHEAD,bh%NHEAD,qb,T.Q,T.K,T.V,T.O,T.nbias+(long)bh*SEQ,lds,dry,Tb); } }
}
#undef SBAR
#undef WAIT_BAR
}
#define GAS __attribute__((address_space(1)))
#define LAS __attribute__((address_space(3)))
typedef unsigned short bf16;
typedef unsigned v4u __attribute__((ext_vector_type(4)));
typedef float f32x4 __attribute__((ext_vector_type(4)));
typedef short bf16x8 __attribute__((ext_vector_type(8)));
typedef GAS unsigned gu32;
typedef GAS unsigned long long gu64;
#define RLX_AGENT __ATOMIC_RELAXED, __HIP_MEMORY_SCOPE_AGENT
#define LDS_WAIT() asm volatile("s_waitcnt lgkmcnt(0)" ::: "memory")
#define VM_WAIT() asm volatile("s_waitcnt vmcnt(0)" ::: "memory")
__device__ __forceinline__ unsigned long long rt() { return __builtin_amdgcn_s_memrealtime(); }
__device__ __forceinline__ unsigned f2bf(float f) { unsigned u = __builtin_bit_cast(unsigned, f); return (u + 0x7fffu + ((u >> 16) & 1u)) >> 16; }
__device__ __forceinline__ unsigned pk2(float lo, float hi) { return f2bf(lo) | (f2bf(hi) << 16); }

#define XB_TMO      128
#define XB_XCNT(j)  (256  + 64 * (j))
#define XB_XSUB(j)  (1280 + 64 * (j))
#define XB_XGEN(j)  (2304 + 64 * (j))
#define XB_TOP      3328
#define XB_TOPGEN   3392
#define XCD_BAR_WORDS 3456
#define XB_SPIN_CAP (1u << 18)

__device__ __forceinline__ unsigned xb_ld(unsigned* p)              { return __hip_atomic_load(p, __ATOMIC_RELAXED, __HIP_MEMORY_SCOPE_AGENT); }
__device__ __forceinline__ unsigned xb_add(unsigned* p, unsigned v) { return __hip_atomic_fetch_add(p, v, __ATOMIC_RELAXED, __HIP_MEMORY_SCOPE_AGENT); }
__device__ __forceinline__ unsigned xb_xcc_id() { return (unsigned)__builtin_amdgcn_s_getreg((3 << 11) | 20) & 0xFu; }
#define XB_SPIN(cond, bar) do { unsigned _sp = 0; while (cond) { __builtin_amdgcn_s_sleep(1); \
    if ((++_sp & 255u) == 0u) { if (xb_ld(&(bar)[XB_TMO])) break; if (_sp > XB_SPIN_CAP) { atomicAdd(&(bar)[XB_TMO], 1u); break; } } } } while (0)

struct XcdBarrier {
    unsigned* bar; unsigned x;
    volatile LAS unsigned* st;
};

__device__ __forceinline__ XcdBarrier xcd_barrier_post(unsigned* bar, volatile LAS unsigned* st) {
    XcdBarrier b; b.bar = bar; b.x = xb_xcc_id(); b.st = st;
    if (threadIdx.x == 0) (void)xb_add(&bar[XB_XCNT(b.x)], 1u);
    return b;
}
__device__ __forceinline__ void xcd_barrier_complete(unsigned* bar, unsigned x, unsigned& nloc, unsigned& nx) {
    const unsigned G = gridDim.x * gridDim.y * gridDim.z;
    unsigned sum, cnt, mine, sp = 0u;
    for (;;) {
        sum = 0u; cnt = 0u; mine = 0u;
#pragma unroll
        for (unsigned j = 0; j < 16; ++j) { const unsigned c = xb_ld(&bar[XB_XCNT(j)]); sum += c; cnt += (c > 0u) ? 1u : 0u; mine = (j == x) ? c : mine; }
        if (sum == G) break;
        __builtin_amdgcn_s_sleep(1);
        if ((++sp & 255u) == 0u) { if (xb_ld(&bar[XB_TMO])) break; if (sp > XB_SPIN_CAP) { atomicAdd(&bar[XB_TMO], 1u); break; } }
    }
    nloc = mine > 0u ? mine : 1u; nx = cnt > 0u ? cnt : 1u;
}

__device__ __forceinline__ void xcd_barrier(const XcdBarrier& b) {
    asm volatile("s_waitcnt vmcnt(0)" ::: "memory");
    __syncthreads();
    if (threadIdx.x == 0) {
        unsigned* bar = b.bar;
        __builtin_amdgcn_s_waitcnt(0);
        unsigned nloc = b.st[0], nx = b.st[1];
        if (nloc == 0u) { xcd_barrier_complete(bar, b.x, nloc, nx); b.st[0] = nloc; b.st[1] = nx; }
        const unsigned old = xb_add(&bar[XB_XSUB(b.x)], 1u);
        const unsigned gen = old / nloc;
        if (old + 1u == (gen + 1u) * nloc) {
            __builtin_amdgcn_fence(__ATOMIC_RELEASE, "agent");
            asm volatile("s_waitcnt vmcnt(0)" ::: "memory");
            const unsigned og = xb_add(&bar[XB_TOP], 1u);
            const unsigned tg = og / nx;
            if (og + 1u == (tg + 1u) * nx) xb_add(&bar[XB_TOPGEN], 1u);
            else XB_SPIN(xb_ld(&bar[XB_TOPGEN]) == tg, bar);
            __builtin_amdgcn_fence(__ATOMIC_ACQUIRE, "agent");
            xb_add(&bar[XB_XGEN(b.x)], 1u);
            asm volatile("s_waitcnt vmcnt(0)" ::: "memory");
        } else {
            XB_SPIN(xb_ld(&bar[XB_XGEN(b.x)]) == gen, bar);
            __builtin_amdgcn_fence(__ATOMIC_ACQUIRE, "agent");
            asm volatile("s_waitcnt vmcnt(0)" ::: "memory");
        }
    }
    __syncthreads();
}
#define CW_XL_MASK(g) (20480 + 64 * (g))
#define CW_XL_SUB(g)  (21504 + 64 * (g))
#define CW_XL_GEN(g)  (22528 + 64 * (g))
__device__ __forceinline__ void group_barrier(unsigned* ctl, unsigned g, unsigned nloc) {
    asm volatile("s_waitcnt vmcnt(0)" ::: "memory");
    __syncthreads();
    if (threadIdx.x == 0) {
        __builtin_amdgcn_s_waitcnt(0);
        const unsigned old = xb_add(&ctl[CW_XL_SUB(g)], 1u);
        const unsigned gen = old / nloc;
        if (old + 1u == (gen + 1u) * nloc) xb_add(&ctl[CW_XL_GEN(g)], 1u);
        else XB_SPIN(xb_ld(&ctl[CW_XL_GEN(g)]) == gen, ctl + 4096);
        __builtin_amdgcn_fence(__ATOMIC_ACQUIRE, "agent");
        asm volatile("s_waitcnt vmcnt(0)" ::: "memory");
    }
    __syncthreads();
}
constexpr int NWAVES = 8;
#ifndef PROBE_MODE
#define PROBE_MODE 0
#endif
#ifndef MK_PER_PHASE
#define MK_PER_PHASE 0
#endif

constexpr float K_LOG2E_F = 1.4426950408889634f;
constexpr int NB = 8, SEQ = 4096, D = 1024, M = NB * SEQ, DFF = 2816, DEPTH = 4;
constexpr int NGU = 2 * DFF;
constexpr int NIN = 2816;
constexpr int KOUT = 1024;
constexpr int HID_P = 3072;
constexpr int ATT_P = 1536;
constexpr int IN_W = 2768;
constexpr int NPHASE = 2 + 8 * DEPTH;
constexpr size_t W_GU1 = 0, W_D1 = W_GU1 + (size_t)NGU * D, W_IN = W_D1 + (size_t)D * DFF, W_OUT = W_IN + (size_t)NIN * D, W_GU2 = W_OUT + (size_t)D * KOUT, W_D2 = W_GU2 + (size_t)NGU * D,
                 W_UK = W_D2 + (size_t)D * DFF, W_UVT = W_UK + 65536, W_LAYER = W_UVT + 65536;
constexpr size_t MiB = 1u << 20;
constexpr size_t WS_CTL = 0, CTL_ZERO_BYTES = 1 * MiB;
constexpr size_t WS_W = 2 * MiB;
constexpr size_t WS_WSC = 166 * MiB;
constexpr size_t WS_HB = 172 * MiB;
constexpr size_t WS_SSQ = 236 * MiB;
constexpr size_t WS_IDX = 238 * MiB;
constexpr size_t WS_CUM = 254 * MiB;
constexpr size_t WS_BIG = 256 * MiB;
constexpr size_t WS_ATT = WS_BIG, WS_QI = WS_BIG + 96 * MiB, WS_FK = WS_BIG + 128 * MiB, WS_FV = WS_BIG + 160 * MiB, WS_CR = WS_BIG + 192 * MiB, WS_CKV = WS_BIG + 208 * MiB,
                 WS_KI = WS_BIG + 216 * MiB, WS_WI = WS_BIG + 220 * MiB, WS_FL = WS_BIG + 221 * MiB, WS_HB8 = WS_BIG + 222 * MiB, WS_END = WS_HB8 + 32 * MiB;
static_assert(WS_W + 4 * W_LAYER * 2 <= WS_HB && (size_t)M * DFF * 2 <= 222 * MiB, "d_ws map");
constexpr int CW_BAR = 4096, CW_TOPKQ = 12288, CW_NRM = 16384;
constexpr int RING_OFF = 0, RING_BYTES = 139264;
constexpr int RSTD_OFF = 131072;
constexpr int LUT_OFF = RING_BYTES;
constexpr int MISC_OFF = LUT_OFF + 8320;
constexpr int LDS_BYTES = MISC_OFF + 256;
static_assert(LDS_BYTES <= 163840, "LDS");

struct Params { const float* in[18]; float* out; unsigned char* ws; int ph_lo, ph_hi; };
struct Frame {
    LAS unsigned char* lds; int tid, lane, wave, vcu, G, bx;
};
__device__ __forceinline__ float wave_sum(float v) {
#pragma unroll
    for (int o = 1; o < 64; o <<= 1) v += __shfl_xor(v, o);
    return v;
}
__device__ __forceinline__ void tr_load(float (&v)[32], const float* __restrict__ W, int ldw, int k0, int c0, int mode, const float* __restrict__ gain, int lane) {
    const int j = lane & 31;
    int col = c0 + j;
    if (mode == 1) col = (j < 8) ? (1216 + j) : (j < 16) ? (2760 + (j - 8)) : -1;
    else if (mode == 2) col = -1;
    const float* wp = W + (size_t)(k0 + (lane >> 5)) * ldw + (col >= 0 ? col : 0);
#pragma unroll
    for (int i = 0; i < 32; ++i) v[i] = (col >= 0) ? wp[(size_t)(2 * i) * ldw] : 0.f;
    if (gain) {
#pragma unroll
        for (int i = 0; i < 32; ++i) v[i] *= gain[k0 + 2 * i + (lane >> 5)];
    }
}
__device__ __forceinline__ void tr_store(const float (&v)[32], int q8, float qs, bf16* WT, int ldt, int n0, int dk0, LAS float* scr, int lane) {
    const int j = lane & 31;
#pragma unroll
    for (int i = 0; i < 32; ++i) scr[(2 * i + (lane >> 5)) * 33 + j] = q8 ? v[i] * qs : v[i];
    LDS_WAIT(); asm volatile("" ::: "memory");
    const int c = lane & 7;
#pragma unroll
    for (int jj = 0; jj < 4; ++jj) { const int n = (lane >> 3) + 8 * jj; const LAS float* s = scr + (8 * c) * 33 + n;
        if (q8) { pg8::u32x2 o; o.x = pg8::f8pk4(s[0 * 33], s[1 * 33], s[2 * 33], s[3 * 33], 1.0f); o.y = pg8::f8pk4(s[4 * 33], s[5 * 33], s[6 * 33], s[7 * 33], 1.0f);
            *(GAS pg8::u32x2*)((GAS unsigned char*)WT + (size_t)(n0 + n) * ldt + dk0 + 8 * c) = o; }
        else { v4u o; o.x = pk2(s[0 * 33], s[1 * 33]); o.y = pk2(s[2 * 33], s[3 * 33]); o.z = pk2(s[4 * 33], s[5 * 33]); o.w = pk2(s[6 * 33], s[7 * 33]);
            *(GAS v4u*)(WT + (size_t)(n0 + n) * ldt + dk0 + 8 * c) = o; } }
    LDS_WAIT(); asm volatile("" ::: "memory");
}
__device__ __forceinline__ void tr_item(const float* __restrict__ W, int ldw, int k0, int c0, int mode, const float* __restrict__ gain, bf16* WT, int ldt, int n0, int dk0, LAS float* scr, int lane) {
    float v[32]; tr_load(v, W, ldw, k0, c0, mode, gain, lane); tr_store(v, 0, 1.0f, WT, ldt, n0, dk0, scr, lane);
}
__device__ __forceinline__ void cb_item(const float* __restrict__ W, int ldw, int c0, int mode, const float* __restrict__ gain, bf16* WT, int n0, float* WSC, LAS float* scr, LAS float* cm, int wave, int lane) {
    float va[32], vb[32];
    tr_load(va, W, ldw, 128 * wave, c0, mode, gain, lane); tr_load(vb, W, ldw, 128 * wave + 64, c0, mode, gain, lane);
    float mx = 0.f;
#pragma unroll
    for (int i = 0; i < 32; ++i) mx = fmaxf(mx, fmaxf(fabsf(va[i]), fabsf(vb[i])));
    mx = fmaxf(mx, __shfl_xor(mx, 32));
    if (lane < 32) cm[wave * 32 + lane] = mx;
    __syncthreads();
    float m = 0.f;
#pragma unroll
    for (int w = 0; w < NWAVES; ++w) m = fmaxf(m, cm[w * 32 + (lane & 31)]);
    const float qs = m > 0.f ? 127.0f / m : 0.f;
    if (wave == 0 && lane < 32) WSC[n0 + lane] = m * (1.0f / 127.0f);
    tr_store(va, 1, qs, WT, D, n0, 128 * wave, scr, lane); tr_store(vb, 1, qs, WT, D, n0, 128 * wave + 64, scr, lane);
    __syncthreads();
}
__device__ __forceinline__ void cb2_item(const float* __restrict__ W, int c0, bf16* WT, int n0, float* WSC, LAS float* scr, LAS float* cm, int wave, int lane) {
    float mx = 0.f;
    for (int kb = wave; kb < DFF / 64; kb += 2 * NWAVES) { float v[32], v2[32]; const bool two = kb + NWAVES < DFF / 64;
        tr_load(v, W, D, 64 * kb, c0, 0, nullptr, lane); if (two) tr_load(v2, W, D, 64 * (kb + NWAVES), c0, 0, nullptr, lane);
#pragma unroll
        for (int i = 0; i < 32; ++i) mx = fmaxf(mx, fabsf(v[i]));
        if (two) {
#pragma unroll
            for (int i = 0; i < 32; ++i) mx = fmaxf(mx, fabsf(v2[i])); } }
    mx = fmaxf(mx, __shfl_xor(mx, 32));
    if (lane < 32) cm[wave * 32 + lane] = mx;
    __syncthreads();
    float m = 0.f;
#pragma unroll
    for (int w = 0; w < NWAVES; ++w) m = fmaxf(m, cm[w * 32 + (lane & 31)]);
    const float qs = m > 0.f ? 127.0f / m : 0.f;
    if (wave == 0 && lane < 32) WSC[n0 + lane] = m * (1.0f / 127.0f);
    for (int kb = wave; kb < DFF / 64; kb += 2 * NWAVES) { float v[32], v2[32]; const bool two = kb + NWAVES < DFF / 64;
        tr_load(v, W, D, 64 * kb, c0, 0, nullptr, lane); if (two) tr_load(v2, W, D, 64 * (kb + NWAVES), c0, 0, nullptr, lane);
        tr_store(v, 1, qs, WT, DFF, n0, 64 * kb, scr, lane); if (two) tr_store(v2, 1, qs, WT, DFF, n0, 64 * (kb + NWAVES), scr, lane); }
    __syncthreads();
}
constexpr int IT_FFN = 1408;
constexpr int IT_WIN = 88 * 16, IT_WOF = 32 * 16;
constexpr int IT_TR_LAYER = IT_WOF;
constexpr int IT_CB_LAYER = 5 * 88 + 2 * 32;
constexpr int WSC_GU1 = 0, WSC_GU2 = NGU, WSC_IN = 2 * NGU, WSC_D1 = 2 * NGU + NIN, WSC_D2 = WSC_D1 + D, WSC_LAYER = WSC_D2 + D;
typedef const __attribute__((address_space(4))) Params* kparams_t;
__device__ __forceinline__ void prologue_phase(kparams_t P, Frame& F) {
    LAS float* scr = (LAS float*)(F.lds + RING_OFF + F.wave * 16384);
    const int gw = F.vcu * NWAVES + F.wave, NGW = F.G * NWAVES;
    bf16* Wall = (bf16*)(P->ws + WS_W);
    for (int e = (F.vcu * NWAVES + F.wave) * 64 + F.lane; e < DEPTH * 65536; e += F.G * NWAVES * 64) {
        const int l = e >> 16, r = e & 65535;
        bf16* Wl = Wall + (size_t)l * W_LAYER;
        Wl[W_UK + r] = (bf16)f2bf(P->in[9][(size_t)l * 65536 + r]);
        const int h = r >> 13, d = (r >> 7) & 63, c = r & 127;
        Wl[W_UVT + r] = (bf16)f2bf(P->in[10][(size_t)l * 65536 + ((size_t)c * 8 + h) * 64 + d]);
    }
    { LAS float* cm = (LAS float*)(F.lds + RING_OFF + NWAVES * 16384);
      for (int it = F.vcu; it < DEPTH * IT_CB_LAYER; it += F.G) {
        constexpr int NLIGHT = DEPTH * 5 * 88;
        const int l = it < NLIGHT ? it / (5 * 88) : (it - NLIGHT) / 64; const int r = it < NLIGHT ? it % (5 * 88) : 5 * 88 + (it - NLIGHT) % 64, mat = r / 88, nb = r % 88;
        bf16* Wl = Wall + (size_t)l * W_LAYER; float* wsc = (float*)(P->ws + WS_WSC) + (size_t)l * WSC_LAYER;
        if (r >= 5 * 88) { const int f = (r - 5 * 88) >> 5, nb2 = (r - 5 * 88) & 31;
            cb2_item(P->in[f ? 15 : 4] + (size_t)l * DFF * D, 32 * nb2, Wl + (f ? W_D2 : W_D1), 32 * nb2, wsc + (f ? WSC_D2 : WSC_D1), scr, cm, F.wave, F.lane); }
        else if (mat < 4) { const int f = mat >> 1, which = mat & 1;
            cb_item(P->in[(f ? 13 : 2) + which] + (size_t)l * D * DFF, DFF, 32 * nb, 0, P->in[f ? 12 : 1] + l * D, Wl + (f ? W_GU2 : W_GU1), 256 * (nb >> 2) + 32 * (nb & 3) + 128 * which, wsc + (f ? WSC_GU2 : WSC_GU1), scr, cm, F.wave, F.lane); }
        else { int c0 = 0, n0 = 0, mode = 0;
            if (nb < 16) { c0 = 32 * nb; n0 = 32 * nb; }
            else if (nb < 32) { c0 = 640 + 32 * (nb - 16); n0 = 512 + 32 * (nb - 16); }
            else if (nb < 80) { c0 = 1224 + 32 * (nb - 32); n0 = 1024 + 32 * (nb - 32); }
            else if (nb < 84) { c0 = 512 + 32 * (nb - 80); n0 = 2560 + 32 * (nb - 80); }
            else if (nb < 86) { c0 = 1152 + 32 * (nb - 84); n0 = 2688 + 32 * (nb - 84); }
            else if (nb == 86) { mode = 1; n0 = 2752; }
            else { mode = 2; n0 = 2784; }
            cb_item(P->in[6] + (size_t)l * D * IN_W, IN_W, c0, mode, P->in[5] + l * D, Wl + W_IN, n0, wsc + WSC_IN, scr, cm, F.wave, F.lane); }
      } }
    for (int it = gw; it < DEPTH * IT_TR_LAYER; it += NGW) {
        const int l = it / IT_TR_LAYER; int r = it % IT_TR_LAYER;
        bf16* Wl = Wall + (size_t)l * W_LAYER;
        { const int kb = r / 32, nb = r % 32, k0 = 64 * kb;
          tr_item(P->in[11] + (size_t)l * D * D, D, k0, 32 * nb, 0, nullptr, Wl + W_OUT, KOUT, 32 * nb, (k0 < 512) ? 512 + k0 : k0 - 512, scr, F.lane); }
    }
    bf16* HB = (bf16*)(P->ws + WS_HB); float* SSQ = (float*)(P->ws + WS_SSQ);
    for (int m0 = 4 * gw; m0 < M; m0 += 4 * NGW) {
        f32x4 v[4][4];
#pragma unroll
        for (int r = 0; r < 4; ++r) { const GAS f32x4* xr = (const GAS f32x4*)(P->in[0] + (size_t)(m0 + r) * D) + F.lane;
#pragma unroll
            for (int j = 0; j < 4; ++j) v[r][j] = xr[64 * j]; }
#pragma unroll
        for (int r = 0; r < 4; ++r) { const int m = m0 + r; float s = 0.f;
#pragma unroll
            for (int j = 0; j < 4; ++j) s += (v[r][j].x * v[r][j].x + v[r][j].y * v[r][j].y) + (v[r][j].z * v[r][j].z + v[r][j].w * v[r][j].w);
            s = wave_sum(s);
            GAS unsigned long long* o8 = (GAS unsigned long long*)(HB + (size_t)m * D) + F.lane;
#pragma unroll
            for (int j = 0; j < 4; ++j) o8[64 * j] = (unsigned long long)pk2(v[r][j].x, v[r][j].y) | ((unsigned long long)pk2(v[r][j].z, v[r][j].w) << 32);
            GAS unsigned* o4 = (GAS unsigned*)(P->ws + WS_HB8 + (size_t)m * D) + F.lane;
#pragma unroll
            for (int j = 0; j < 4; ++j) o4[64 * j] = pg8::f8pk4(v[r][j].x, v[r][j].y, v[r][j].z, v[r][j].w, pg8::F8_HS);
            if (F.lane < 16) SSQ[(size_t)m * 16 + F.lane] = (F.lane == 0) ? s : 0.f; }
    }
}
typedef unsigned short u16;
typedef unsigned u32x4t __attribute__((ext_vector_type(4)));
typedef float f32x2t __attribute__((ext_vector_type(2)));
constexpr int TOPK = 256;
__device__ __forceinline__ void scan_unit(const float* FL, const float* bfg, float* CUM, int bh, Frame& F) {
    const int b = bh >> 3, h = bh & 7; const float bf = bfg[h];
    const float* src = FL + ((size_t)b * SEQ + 8 * F.tid) * 8 + h;
    float pre[8]; float run = 0.f;
#pragma unroll
    for (int e = 0; e < 8; ++e) { const float x = src[e * 8] + bf; const float lf = fminf(x, 0.f) - __logf(1.0f + __expf(-fabsf(x))); run += lf; pre[e] = run; }
    float inc = run;
#pragma unroll
    for (int o = 1; o < 64; o <<= 1) { const float t = __shfl_up(inc, o); if (F.lane >= o) inc += t; }
    LAS float* wt = (LAS float*)(F.lds + RING_OFF);
    __syncthreads();
    if (F.lane == 63) wt[F.wave] = inc;
    __syncthreads();
    float off = inc - run;
    for (int w = 0; w < F.wave; ++w) off += wt[w];
    float* dst = CUM + (size_t)bh * SEQ + 8 * F.tid;
    f32x4 o0, o1;
    o0[0] = -K_LOG2E_F * (off + pre[0]); o0[1] = -K_LOG2E_F * (off + pre[1]); o0[2] = -K_LOG2E_F * (off + pre[2]); o0[3] = -K_LOG2E_F * (off + pre[3]);
    o1[0] = -K_LOG2E_F * (off + pre[4]); o1[1] = -K_LOG2E_F * (off + pre[5]); o1[2] = -K_LOG2E_F * (off + pre[6]); o1[3] = -K_LOG2E_F * (off + pre[7]);
    *(f32x4*)dst = o0; *(f32x4*)(dst + 4) = o1;
    __syncthreads();
}
__device__ __forceinline__ void ckv_rows(const float* CR, const float* g, bf16* CKV, Frame& F) {
    const bool xb = F.G == 256;
    const int gw = xb ? (F.vcu & 31) * NWAVES + F.wave : F.vcu * NWAVES + F.wave, NGW = xb ? 32 * NWAVES : F.G * NWAVES, mb = xb ? (F.vcu >> 5) * SEQ : 0, me = xb ? SEQ : M;
    const float g0 = g[2 * F.lane], g1 = g[2 * F.lane + 1];
    constexpr int RT = 8;
    for (int m0 = gw; m0 < me; m0 += RT * NGW) {
        float v0[RT], v1[RT];
#pragma unroll
        for (int r = 0; r < RT; ++r) { const int mr = m0 + r * NGW; const int m = mb + (mr < me ? mr : m0); const f32x2t v = *(const f32x2t*)(CR + (size_t)m * 128 + 2 * F.lane); v0[r] = v[0]; v1[r] = v[1]; }
#pragma unroll
        for (int r = 0; r < RT; ++r) { const int mr = m0 + r * NGW; if (mr >= me) break; const int m = mb + mr; const float ss = wave_sum(v0[r] * v0[r] + v1[r] * v1[r]); const float rs = 1.0f / sqrtf(ss * (1.0f / 128.0f) + 1e-6f);
            *(GAS unsigned*)(CKV + (size_t)m * 128 + 2 * F.lane) = pk2(v0[r] * rs * g0, v1[r] * rs * g1); }
    }
}
__device__ __forceinline__ float tk_sum4(float t0, float t1, float t2, float t3) {
    float p;
    asm("v_add_f32 %0, %1, %2\n\tv_add_f32 %0, %0, %3\n\tv_add_f32 %0, %0, %4" : "=&v"(p) : "v"(t0), "v"(t1), "v"(t2), "v"(t3));
    return p;
}
#define TK_WAITV(n) asm volatile("s_waitcnt vmcnt(" #n ")" ::: "memory")
typedef float f32x16 __attribute__((ext_vector_type(16)));
constexpr int TK_RING = 0, TK_OST = 98304, TK_HIST = 106496, TK_CAND = 122880;
__device__ __forceinline__ bool topk_unit(const bf16* QI, const bf16* KI, const float* WI, u16* IDX, int b, int u, gu32* qctr, int G, LAS unsigned* nxw, bool pre, int& nxt, Frame& F) {
    const int lane = F.lane, wave = F.wave;
    const int t0 = 16 * u, tA = t0 + 2 * wave;
    const int m16 = lane & 15, g = lane >> 4, qs = g & 1, qi = ((lane >> 5) << 4) | m16;
    LAS unsigned char* ring = F.lds + RING_OFF + TK_RING;
    LAS u16* ost = (LAS u16*)(F.lds + RING_OFF + TK_OST + wave * 1024);
    unsigned got_ = 0u;
    if (F.tid == 0) { const unsigned old_ = __hip_atomic_fetch_add(qctr, 1u, __ATOMIC_RELAXED, __HIP_MEMORY_SCOPE_AGENT); got_ = (G == 256) ? (((32u + old_) << 3) | (unsigned)b) : (unsigned)G + old_; }
    if (t0 < TOPK) {
        u32x4t v; const unsigned k0 = 8u * (unsigned)qi;
        v.x = k0 | ((k0 + 1) << 16); v.y = (k0 + 2) | ((k0 + 3) << 16); v.z = (k0 + 4) | ((k0 + 5) << 16); v.w = (k0 + 6) | ((k0 + 7) << 16);
        *(GAS u32x4t*)(IDX + ((size_t)b * SEQ + tA + qs) * TOPK + 8 * qi) = v;
        if (F.tid == 0) *nxw = got_;
        __syncthreads();
        nxt = (int)*nxw;
        return false;
    }
    const int nch = (t0 + 16 + 255) >> 8;
    const bf16* qrow = QI + ((size_t)b * SEQ + tA + ((m16 >> 2) & 1)) * 512 + (4 * (m16 >> 3) + (m16 & 3)) * 64 + 8 * g;
    bf16x8 a0 = *(const bf16x8*)qrow, a1 = *(const bf16x8*)(qrow + 32);
    { const float wrow = WI[((size_t)b * SEQ + tA + ((m16 >> 2) & 1)) * 8 + 4 * (m16 >> 3) + (m16 & 3)];
      u32x4t r0 = __builtin_bit_cast(u32x4t, a0), r1 = __builtin_bit_cast(u32x4t, a1);
#pragma unroll
      for (int e = 0; e < 4; ++e) { r0[e] = pg8::cvt_pk_bf16(__uint_as_float(r0[e] << 16) * wrow, __uint_as_float(r0[e] & 0xffff0000u) * wrow);
                                    r1[e] = pg8::cvt_pk_bf16(__uint_as_float(r1[e] << 16) * wrow, __uint_as_float(r1[e] & 0xffff0000u) * wrow); }
      a0 = __builtin_bit_cast(bf16x8, r0); a1 = __builtin_bit_cast(bf16x8, r1); }
    const f32x4 wv = *(const f32x4*)(WI + ((size_t)b * SEQ + tA + qs) * 8 + 4 * (g >> 1));
    const float L0 = wv[0] > 0.f ? INFINITY : -INFINITY, L1 = wv[1] > 0.f ? INFINITY : -INFINITY, L2 = wv[2] > 0.f ? INFINITY : -INFINITY, L3 = wv[3] > 0.f ? INFINITY : -INFINITY;
    const int tq = tA + qs;
    f32x16 T0, T1, T2, T3, T4, T5, T6, T7;
    float vmin = INFINITY, vmax = -INFINITY;
    bool did = false;
#if PROBE_MODE == 5
    for (int rep_ = 0; rep_ < 2; ++rep_) {
#else
    {
#endif
    const size_t klane = (size_t)(8 * wave + (lane >> 3)) * 64 + ((lane & 7) ^ (lane >> 3)) * 8;
    const bf16* kp = KI + (size_t)b * SEQ * 64 + klane;
    const unsigned ring_a = (unsigned)(size_t)ring + (unsigned)wave * 1024u;
#define TK_ISSUE_P(ptr, slot) do { _Pragma("unroll") for (int pp = 0; pp < 4; ++pp) attn_body::glds16((ptr) + (size_t)pp * 64 * 64, (unsigned)__builtin_amdgcn_readfirstlane(ring_a + (unsigned)(slot) * 32768u + (unsigned)pp * 8192u)); } while (0)
#define TK_ISSUE(slot) TK_ISSUE_P(kp, slot)
    if (!pre) { TK_WAITV(0); TK_ISSUE(0); }
    if (nch > 1) { kp += 256 * 64; if (!pre) TK_ISSUE(1); }
#define TK_LDB(dst, jj) do { _Pragma("unroll") for (int hh = 0; hh < 2; ++hh) { const int row = 16 * (2 * (jj) + hh) + m16; \
        dst[hh][0] = *(const LAS bf16x8*)(kb + row * 128 + ((g ^ (row & 7)) * 16)); dst[hh][1] = *(const LAS bf16x8*)(kb + row * 128 + (((4 + g) ^ (row & 7)) * 16)); } } while (0)
#define TK_TERM(x, L) __builtin_amdgcn_fmed3f(x, 0.f, L)
#define TK_TILEPAIR(j, MASKED) { \
            if (j < 7) TK_LDB(bn, j + 1); \
            f32x4 c0 = {0.f, 0.f, 0.f, 0.f}, c1 = {0.f, 0.f, 0.f, 0.f}; \
            c0 = __builtin_amdgcn_mfma_f32_16x16x32_bf16(a0, bc[0][0], c0, 0, 0, 0); \
            c1 = __builtin_amdgcn_mfma_f32_16x16x32_bf16(a0, bc[1][0], c1, 0, 0, 0); \
            c0 = __builtin_amdgcn_mfma_f32_16x16x32_bf16(a1, bc[0][1], c0, 0, 0, 0); \
            c1 = __builtin_amdgcn_mfma_f32_16x16x32_bf16(a1, bc[1][1], c1, 0, 0, 0); \
            const float p0 = tk_sum4(TK_TERM(c0[0], L0), TK_TERM(c0[1], L1), TK_TERM(c0[2], L2), TK_TERM(c0[3], L3)); \
            const float p1 = tk_sum4(TK_TERM(c1[0], L0), TK_TERM(c1[1], L1), TK_TERM(c1[2], L2), TK_TERM(c1[3], L3)); \
              \
            const auto sw = __builtin_amdgcn_permlane32_swap(__float_as_uint(p0), __float_as_uint(p1), false, false); \
            const float tot = __uint_as_float(sw[0]) + __uint_as_float(sw[1]); \
            vmin = fminf(vmin, tot); \
            if (MASKED) { const int key = 256 * c + 32 * j + qi; sv[j] = (key <= tq) ? tot : -INFINITY; } else sv[j] = tot; \
            vmax = fmaxf(vmax, sv[j]); \
            if (j < 7) { bc[0][0] = bn[0][0]; bc[0][1] = bn[0][1]; bc[1][0] = bn[1][0]; bc[1][1] = bn[1][1]; } }
    for (int c = 0; c < nch; ++c) {
        if (c + 1 < nch) TK_WAITV(4); else TK_WAITV(0);
        __builtin_amdgcn_s_barrier(); asm volatile("" ::: "memory");
        if (c + 2 < nch) { kp += 256 * 64; TK_ISSUE((c + 2) % 3); }
        const LAS unsigned char* kb = ring + (c % 3) * 32768;
        bf16x8 bc[2][2], bn[2][2]; float sv[8];
        TK_LDB(bc, 0);
        if (c + 1 < nch) {
            TK_TILEPAIR(0, false) TK_TILEPAIR(1, false) TK_TILEPAIR(2, false) TK_TILEPAIR(3, false) TK_TILEPAIR(4, false) TK_TILEPAIR(5, false) TK_TILEPAIR(6, false) TK_TILEPAIR(7, false)
        } else {
            TK_TILEPAIR(0, true) TK_TILEPAIR(1, true) TK_TILEPAIR(2, true) TK_TILEPAIR(3, true) TK_TILEPAIR(4, true) TK_TILEPAIR(5, true) TK_TILEPAIR(6, true) TK_TILEPAIR(7, true)
        }
        T0[c] = sv[0]; T1[c] = sv[1]; T2[c] = sv[2]; T3[c] = sv[3]; T4[c] = sv[4]; T5[c] = sv[5]; T6[c] = sv[6]; T7[c] = sv[7];
    }
#undef TK_TILEPAIR
#undef TK_TERM
    if (F.tid == 0) *nxw = got_;
    asm volatile("s_waitcnt lgkmcnt(0)" ::: "memory"); __builtin_amdgcn_s_barrier(); asm volatile("" ::: "memory");
    nxt = (int)*nxw;
    const int nb = (nxt < 2048) ? (nxt & 7) : -1, nu = 255 - (nxt >> 3);
    if (nb >= 0 && 16 * nu >= TOPK) { const bf16* kq = KI + (size_t)nb * SEQ * 64 + klane; TK_ISSUE_P(kq, 0); if (((16 * nu + 16 + 255) >> 8) > 1) { TK_ISSUE_P(kq + 256 * 64, 1); } did = true; }
    }
#undef TK_ISSUE
#undef TK_ISSUE_P
#undef TK_LDB
#define TK_PASS(BODY, WB) _Pragma("unroll") for (int c = 0; c < 16; ++c) { if (c < nch) { float sv[8]; \
        sv[0] = T0[c]; sv[1] = T1[c]; sv[2] = T2[c]; sv[3] = T3[c]; sv[4] = T4[c]; sv[5] = T5[c]; sv[6] = T6[c]; sv[7] = T7[c]; \
        _Pragma("unroll") for (int j = 0; j < 8; ++j) { const int kbase = 256 * c + 32 * j; BODY(sv[j], j, kbase) } \
        if (WB) { T0[c] = sv[0]; T1[c] = sv[1]; T2[c] = sv[2]; T3[c] = sv[3]; T4[c] = sv[4]; T5[c] = sv[5]; T6[c] = sv[6]; T7[c] = sv[7]; } } }
    LAS unsigned* hist = (LAS unsigned*)(F.lds + RING_OFF + TK_HIST + wave * 2048);
    LAS unsigned* cand = (LAS unsigned*)(F.lds + RING_OFF + TK_CAND + wave * 1024) + qs * 128;
    { unsigned zz = 0u; asm volatile("" : "+v"(zz)); const u32x4t z = {zz, zz, zz, zz}; *(LAS u32x4t*)(hist + 8 * lane) = z; *(LAS u32x4t*)(hist + 8 * lane + 4) = z; *(LAS u32x4t*)((LAS unsigned char*)ost + 16 * lane) = z; }
#pragma unroll
    for (int o = 1; o < 16; o <<= 1) { vmin = fminf(vmin, __shfl_xor(vmin, o)); vmax = fmaxf(vmax, __shfl_xor(vmax, o)); }
    vmin = fminf(vmin, __shfl_xor(vmin, 32)); vmax = fmaxf(vmax, __shfl_xor(vmax, 32));
    const float scale = 16777000.0f / fmaxf(vmax - vmin, 1e-30f), off = 2.0f - vmin * scale;
    LAS unsigned* myh = hist + qs * 256;
#define TK_B_HIST(v, j, kbase) { unsigned uu; asm("v_cvt_u32_f32 %0, %1" : "=v"(uu) : "v"(fmaf(v, scale, off))); v = __uint_as_float(uu); \
        __hip_atomic_fetch_add(myh + (uu >> 16), 1u, __ATOMIC_RELAXED, __HIP_MEMORY_SCOPE_WORKGROUP); }
    TK_PASS(TK_B_HIST, 1)
#undef TK_B_HIST
    int B1, chi;
    { const u32x4t h0 = *(const LAS u32x4t*)(myh + 8 * qi), h1 = *(const LAS u32x4t*)(myh + 8 * qi + 4);
      const int hb[8] = {(int)h0.x, (int)h0.y, (int)h0.z, (int)h0.w, (int)h1.x, (int)h1.y, (int)h1.z, (int)h1.w};
      const int tot = ((hb[0] + hb[1]) + (hb[2] + hb[3])) + ((hb[4] + hb[5]) + (hb[6] + hb[7]));
      int S = tot;
#pragma unroll
      for (int o = 1; o < 16; o <<= 1) { const int tt = __shfl_down(S, o); if (m16 + o < 16) S += tt; }
      { const int hi_tot = __shfl(S, 32 + 16 * qs); if (lane < 32) S += hi_tot; }
      int cum = S - tot, Bl = -1, cl = 0;
#pragma unroll
      for (int k = 7; k >= 0; --k) { if (Bl < 0) { if (cum + hb[k] >= TOPK) { Bl = 8 * qi + k; cl = cum; } else cum += hb[k]; } }
      const bool finder = (S >= TOPK) && (S - tot < TOPK);
      const unsigned long long fm = __ballot(finder) & (0x0000FFFF0000FFFFull << (16 * qs));
      const int src = (int)__ffsll((long long)fm) - 1;
      B1 = __shfl(Bl, src); chi = __shfl(cl, src); }
    const unsigned UL = (unsigned)B1 << 16, UH = UL + 65536u;
    LAS unsigned* ccnt = myh;
    *ccnt = 0u;
    unsigned gm0 = 0u, gm1 = 0u, gm2 = 0u, gm3 = 0u;
#define TK_B_COLLECT(v, j, kbase) { const unsigned d = __float_as_uint(v) - UL; \
        if (d < 65536u) { const unsigned slot = __hip_atomic_fetch_add(ccnt, 1u, __ATOMIC_RELAXED, __HIP_MEMORY_SCOPE_WORKGROUP);     \
            if (slot < 128u) cand[slot] = (d << 12) | (unsigned)(4095 - (kbase + qi)); } }
#define TK_CGROUP(K, GM) if (nch > 4 * (K)) { \
        _Pragma("unroll") for (int cc = 0; cc < 4; ++cc) { const int c = 4 * (K) + cc; if (c < nch) { float sv[8]; bool anyeq = false; \
            sv[0] = T0[c]; sv[1] = T1[c]; sv[2] = T2[c]; sv[3] = T3[c]; sv[4] = T4[c]; sv[5] = T5[c]; sv[6] = T6[c]; sv[7] = T7[c]; \
            _Pragma("unroll") for (int j = 0; j < 8; ++j) { const unsigned uu = __float_as_uint(sv[j]); GM = (GM << 1) | ((uu >= UH) ? 1u : 0u); anyeq |= ((uu - UL) < 65536u); } \
            if (__any(anyeq)) { _Pragma("unroll") for (int j = 0; j < 8; ++j) { const int kbase = 256 * c + 32 * j; TK_B_COLLECT(sv[j], j, kbase) } } } } \
        { const int cend_ = (nch < 4 * (K) + 4) ? nch : 4 * (K) + 4; GM <<= 8 * (4 * (K) + 4 - cend_); } }
    TK_CGROUP(0, gm0) TK_CGROUP(1, gm1) TK_CGROUP(2, gm2) TK_CGROUP(3, gm3)
#undef TK_CGROUP
#undef TK_B_COLLECT
    LAS u16* oq = ost + qs * TOPK;
    const int cbA = __builtin_amdgcn_readfirstlane((int)hist[0]), cbB = __builtin_amdgcn_readfirstlane((int)hist[256]);
    const int mA = cbA < 128 ? cbA : 128, mB = cbB < 128 ? cbB : 128, mm = qs ? mB : mA, mx = mA > mB ? mA : mB;
    { const int cnt = (__popc(gm0) + __popc(gm1)) + (__popc(gm2) + __popc(gm3));
      int inc = cnt;
#pragma unroll
      for (int o = 1; o < 16; o <<= 1) { const int tt = __shfl_up(inc, o); if (m16 >= o) inc += tt; }
      { const int lo_tot = __shfl(inc, 15 + 16 * qs); if (lane >= 32) inc += lo_tot; }
      int pos = inc - cnt;
#define TK_WRITE_WORD(K, GM) { unsigned m_ = GM; while (__any(m_ != 0u)) { if (m_) { const int lz = __clz((int)m_); oq[pos] = (u16)(32 * (32 * (K) + lz) + qi); ++pos; m_ &= 0x7fffffffu >> lz; } } }
      TK_WRITE_WORD(0, gm0) TK_WRITE_WORD(1, gm1) TK_WRITE_WORD(2, gm2) TK_WRITE_WORD(3, gm3)
#undef TK_WRITE_WORD
    }
    { const int need = TOPK - chi;
      unsigned ck[4]; int rk[4];
#pragma unroll
      for (int e = 0; e < 4; ++e) { ck[e] = (qi + 32 * e < mm) ? cand[qi + 32 * e] : 0u; rk[e] = 0; }
      for (int i = 0; i < mx; i += 4) { const u32x4t v4 = *(const LAS u32x4t*)(cand + i);
#pragma unroll
          for (int q = 0; q < 4; ++q) { const unsigned v = v4[q]; const bool live = i + q < mm;
#pragma unroll
              for (int e = 0; e < 4; ++e) rk[e] += (live && v > ck[e]) ? 1 : 0; } }
#pragma unroll
      for (int e = 0; e < 4; ++e) if ((qi + 32 * e < mm) && rk[e] < need) oq[chi + rk[e]] = (u16)(4095u - (ck[e] & 4095u)); }
    LDS_WAIT(); asm volatile("" ::: "memory");
    *(GAS u32x4t*)(IDX + ((size_t)b * SEQ + tA) * TOPK + 8 * lane) = *(const LAS u32x4t*)((const LAS unsigned char*)ost + 16 * lane);
    LDS_WAIT(); asm volatile("" ::: "memory");
#undef TK_PASS
    return did;
}
#undef TK_WAITV
constexpr int SP_WAVE_BYTES = 17408;
__device__ __forceinline__ unsigned sp_swz(unsigned row) { return ((row & 3u) << 2) | ((row >> 2) & 3u); }
__device__ __forceinline__ unsigned sp_off(unsigned row, unsigned ch) { return 256u * (4u * (row & 7u) + (row >> 3)) + 16u * (ch ^ sp_swz(row)); }
__device__ __forceinline__ void sp_dma8(const bf16* base, unsigned lds_dst, unsigned msk, unsigned k0, unsigned k1, unsigned k2, unsigned k3, unsigned k4, unsigned k5, unsigned k6, unsigned k7,
                                        unsigned l0, unsigned l1, unsigned l2, unsigned l3, unsigned l4, unsigned l5, unsigned l6, unsigned l7) {
    unsigned keep;
    asm volatile("s_waitcnt lgkmcnt(0)\n\ts_mov_b32 %0, m0\n\ts_mov_b32 m0, %9\n\tv_and_or_b32 %1, %1, %11, %12\n\ts_nop 1\n\t"
                 "global_load_lds_dwordx4 %1, %10\n\ts_add_u32 m0, m0, 0x400\n\tv_and_or_b32 %2, %2, %11, %13\n\t"
                 "global_load_lds_dwordx4 %2, %10\n\ts_add_u32 m0, m0, 0x400\n\tv_and_or_b32 %3, %3, %11, %14\n\t"
                 "global_load_lds_dwordx4 %3, %10\n\ts_add_u32 m0, m0, 0x400\n\tv_and_or_b32 %4, %4, %11, %15\n\t"
                 "global_load_lds_dwordx4 %4, %10\n\ts_add_u32 m0, m0, 0x400\n\tv_and_or_b32 %5, %5, %11, %16\n\t"
                 "global_load_lds_dwordx4 %5, %10\n\ts_add_u32 m0, m0, 0x400\n\tv_and_or_b32 %6, %6, %11, %17\n\t"
                 "global_load_lds_dwordx4 %6, %10\n\ts_add_u32 m0, m0, 0x400\n\tv_and_or_b32 %7, %7, %11, %18\n\t"
                 "global_load_lds_dwordx4 %7, %10\n\ts_add_u32 m0, m0, 0x400\n\tv_and_or_b32 %8, %8, %11, %19\n\t"
                 "global_load_lds_dwordx4 %8, %10\n\ts_mov_b32 m0, %0"
                 : "=&s"(keep), "+v"(k0), "+v"(k1), "+v"(k2), "+v"(k3), "+v"(k4), "+v"(k5), "+v"(k6), "+v"(k7)
                 : "s"(lds_dst), "s"(base), "s"(msk), "v"(l0), "v"(l1), "v"(l2), "v"(l3), "v"(l4), "v"(l5), "v"(l6), "v"(l7) : "memory", "scc");
}
typedef short v4i16_t __attribute__((ext_vector_type(4)));
__device__ __forceinline__ void build_lut(const float* rel_bias, Frame& F) {
    LAS float* lut = (LAS float*)(F.lds + LUT_OFF);
    for (int e = F.tid; e < 130 * 16; e += NWAVES * 64) { const int d = (e >> 4) - 1, hh = e & 15; int bk = d < 0 ? 0 : d;
        if (d >= 16) { bk = 16 + (int)(logf((float)d * (1.0f / 16.0f)) / 2.0794415416798357f * 16.0f); bk = bk < 31 ? bk : 31; }
        const float v = (hh < 8) ? rel_bias[bk * 8 + hh] * K_LOG2E_F : 0.f;
        lut[e] = (d < 0) ? -INFINITY : v; }
}
__device__ __forceinline__ void sparse_phase(bf16* ATT, const bf16* CKV, const u16* IDX, const bf16* Wl, int q0, int qstride, int nq, Frame& F, int dry = 0) {
    typedef unsigned u32x2t __attribute__((ext_vector_type(2)));
    const int lane = F.lane, n = lane & 15, g = lane >> 4;
    LAS unsigned char* wl = F.lds + RING_OFF + F.wave * SP_WAVE_BYTES;
    const LAS unsigned char* lutn = F.lds + LUT_OFF + 64 + 4 * n;
    const unsigned rA0 = 8u * (n >> 2) + (n & 3u), rA1 = rA0 + 4u;
    const unsigned q4 = (unsigned)n >> 2, p4 = (unsigned)n & 3u;
    u32x2t ixn = {0u, 0u};
    bf16x8 qf[4];
    const unsigned wl_a = (unsigned)(size_t)wl;
    unsigned lt[8];
#pragma unroll
    for (int i = 0; i < 8; ++i) lt[i] = 16u * ((unsigned)n ^ sp_swz(8u * g + i));
#define SP_KEY(KW, i) (((i) & 1) ? ((KW)[(i) >> 1] >> 16) : ((KW)[(i) >> 1] & 0xffffu))
#define SP_ISSUE(bufoff, KW, CB) sp_dma8((CB), (unsigned)__builtin_amdgcn_readfirstlane(wl_a + (unsigned)(bufoff)), 0x00ffff00u, \
        (KW)[0] << 8, (KW)[0] >> 8, (KW)[1] << 8, (KW)[1] >> 8, (KW)[2] << 8, (KW)[2] >> 8, (KW)[3] << 8, (KW)[3] >> 8, lt[0], lt[1], lt[2], lt[3], lt[4], lt[5], lt[6], lt[7])
#define SP_LANDED() asm volatile("s_waitcnt vmcnt(0)" ::: "memory")
#define SP_LOADQ(dst, row) do { _Pragma("unroll") for (int s = 0; s < 4; ++s) { bf16x8 z = {0, 0, 0, 0, 0, 0, 0, 0}; dst[s] = (n < 8) ? *(const bf16x8*)(ATT + (size_t)(row) * 1536 + 512 + n * 128 + 32 * s + 8 * g) : z; } } while (0)
    const int base0 = q0 - F.wave, hh = F.wave;
    LAS unsigned* qctr = (LAS unsigned*)(F.lds + MISC_OFF + 64);
    if (F.tid == 0) *qctr = 8u;
    __syncthreads();
    if (nq == 16) {
        typedef unsigned u32x2t __attribute__((ext_vector_type(2)));
        bf16x8 wa[8][2], qa[8][2];
        const bf16* uk = Wl + W_UK + (size_t)n * 512 + hh * 64 + 8 * g;
#pragma unroll
        for (int ct = 0; ct < 8; ++ct) { wa[ct][0] = *(const bf16x8*)(uk + (size_t)ct * 16 * 512); wa[ct][1] = *(const bf16x8*)(uk + (size_t)ct * 16 * 512 + 32); }
#pragma unroll
        for (int tt = 0; tt < 8; ++tt) { const bf16* ar = ATT + (size_t)(base0 + tt + n * qstride) * 1536 + 512 + hh * 64 + 8 * g; qa[tt][0] = *(const bf16x8*)ar; qa[tt][1] = *(const bf16x8*)(ar + 32); }
        asm volatile("s_waitcnt vmcnt(0)" ::: "memory"); __syncthreads();
#pragma unroll
        for (int tt = 0; tt < 8; ++tt) { bf16* ar = ATT + (size_t)(base0 + tt + n * qstride) * 1536 + 512 + hh * 128 + 4 * g;
#pragma unroll
            for (int ct = 0; ct < 8; ++ct) { f32x4 d = {0.f, 0.f, 0.f, 0.f};
                d = __builtin_amdgcn_mfma_f32_16x16x32_bf16(wa[ct][0], qa[tt][0], d, 0, 0, 0);
                d = __builtin_amdgcn_mfma_f32_16x16x32_bf16(wa[ct][1], qa[tt][1], d, 0, 0, 0);
                u32x2t w; w.x = pk2(d[0], d[1]); w.y = pk2(d[2], d[3]);
                *(GAS u32x2t*)(ar + 16 * ct) = w; } }
        asm volatile("s_waitcnt vmcnt(0)" ::: "memory"); __syncthreads();
    }
    *(LAS u32x2t*)(wl + 16384 + 8 * lane) = *(const GAS u32x2t*)(IDX + (size_t)q0 * TOPK + 4 * lane);
    SP_LOADQ(qf, q0);
    LDS_WAIT(); asm volatile("" ::: "memory");
    u32x4t kw0 = *(const LAS u32x4t*)(wl + 16384 + 16 * g), kw1 = *(const LAS u32x4t*)(wl + 16384 + 64 + 16 * g), kw2 = kw1;
    { const bf16* cb = CKV + (size_t)(q0 >> 12) * SEQ * 128; SP_ISSUE(0, kw0, cb); }
    unsigned one2; asm volatile("s_mov_b32 %0, 0x3f803f80" : "=s"(one2));
    u32x4t onew = {one2, one2, one2, one2};
    asm volatile("" : "+v"(onew));
    const bf16x8 ones = __builtin_bit_cast(bf16x8, onew);
    int row = q0, rown = q0; bool more = true;
    for (int k = 0; more; ++k) {
        const int t = row & (SEQ - 1);
        { unsigned nx_ = 0u; if (lane == 0) nx_ = __hip_atomic_fetch_add(qctr, 1u, __ATOMIC_RELAXED, __HIP_MEMORY_SCOPE_WORKGROUP);
          const int nxt = __builtin_amdgcn_readfirstlane((int)nx_); more = nxt < 8 * nq; rown = base0 + (nxt & 7) + (nxt >> 3) * qstride; }
        const LAS unsigned char* idxs_b = wl + 16384 + (k & 1) * 512 + 16 * g;
        const LAS unsigned char* idxn_b = wl + 16384 + ((k + 1) & 1) * 512 + 16 * g;
        LAS unsigned char* idxn = wl + 16384 + ((k + 1) & 1) * 512;
        const bf16* cb = CKV + (size_t)(row >> 12) * SEQ * 128; const bf16* cbn = CKV + (size_t)(rown >> 12) * SEQ * 128;
        float m_run = 0.f;
        f32x4 O[8], Ls = {0.f, 0.f, 0.f, 0.f};
#pragma unroll
        for (int cc = 0; cc < 8; ++cc) O[cc] = (f32x4){0.f, 0.f, 0.f, 0.f};
#define SP_STEP(c) { \
        LAS unsigned char* cur = wl + ((c) & 1) * 8192; \
        SP_LANDED();     \
        if ((c) < 7) SP_ISSUE((((c) + 1) & 1) * 8192, kw1, cb); else if (more) SP_ISSUE(0, kw1, cbn); \
        kw2 = *(const LAS u32x4t*)(((c) < 6 ? idxs_b : idxn_b) + 64 * (((c) + 2) & 7)); \
        if ((c) == 0 && more) ixn = *(const GAS u32x2t*)(IDX + (size_t)rown * TOPK + 4 * lane); \
        if ((c) == 4 && more) *(LAS u32x2t*)(idxn + 8 * lane) = ixn; \
          \
        float bsm[8]; \
        _Pragma("unroll") for (int i = 0; i < 8; ++i) { const int dist = t - (int)SP_KEY(kw0, i); const int dcl = dist < -1 ? -1 : (dist > 128 ? 128 : dist); \
            const float lv = *(const LAS float*)(lutn + 64 * dcl); bsm[i] = ((c) == 0) ? lv : lv - m_run; } \
          \
        bf16x8 kq[4][2]; \
        _Pragma("unroll") for (int s = 0; s < 4; ++s) { kq[s][0] = *(const LAS bf16x8*)(cur + sp_off(rA0, 4 * s + g)); kq[s][1] = *(const LAS bf16x8*)(cur + sp_off(rA1, 4 * s + g)); } \
        asm volatile("" ::: "memory"); \
        f32x4 S0 = {bsm[0], bsm[1], bsm[2], bsm[3]}, S1 = {bsm[4], bsm[5], bsm[6], bsm[7]}; \
        _Pragma("unroll") for (int s = 0; s < 4; ++s) { \
            S0 = __builtin_amdgcn_mfma_f32_16x16x32_bf16(kq[s][0], qf[s], S0, 0, 0, 0); \
            S1 = __builtin_amdgcn_mfma_f32_16x16x32_bf16(kq[s][1], qf[s], S1, 0, 0, 0); } \
        if ((c) == 7 && more) SP_LOADQ(qf, rown);     \
        v4i16_t vlo[8], vhi[8]; \
        _Pragma("unroll") for (int cc = 0; cc < 8; ++cc) { \
            vlo[cc] = __builtin_amdgcn_ds_read_tr16_b64_v4i16((LAS v4i16_t*)(cur + sp_off(8u * g + q4, 2u * cc + (p4 >> 1)) + 8u * (p4 & 1u))); \
            vhi[cc] = __builtin_amdgcn_ds_read_tr16_b64_v4i16((LAS v4i16_t*)(cur + sp_off(8u * g + 4u + q4, 2u * cc + (p4 >> 1)) + 8u * (p4 & 1u))); } \
        asm volatile("" ::: "memory"); \
          \
        float mx = fmaxf(fmaxf(fmaxf(S0[0], S0[1]), fmaxf(S0[2], S0[3])), fmaxf(fmaxf(S1[0], S1[1]), fmaxf(S1[2], S1[3]))); \
        if ((c) == 0) {     \
            { const auto r1 = __builtin_amdgcn_permlane16_swap(__float_as_uint(mx), __float_as_uint(mx), false, false); mx = fmaxf(__uint_as_float(r1[0]), __uint_as_float(r1[1])); } \
            { const auto r2 = __builtin_amdgcn_permlane32_swap(__float_as_uint(mx), __float_as_uint(mx), false, false); mx = fmaxf(__uint_as_float(r2[0]), __uint_as_float(r2[1])); } \
            m_run = mx; \
            _Pragma("unroll") for (int e = 0; e < 4; ++e) { S0[e] -= mx; S1[e] -= mx; } \
        } else if (__any(mx > 16.0f)) {     \
            mx = fmaxf(mx, __shfl_xor(mx, 16)); mx = fmaxf(mx, __shfl_xor(mx, 32)); \
                \
            const float dl = fmaxf(mx, 0.f); const float alpha = __builtin_amdgcn_exp2f(-dl); \
            m_run += dl; \
            _Pragma("unroll") for (int e = 0; e < 4; ++e) { S0[e] -= dl; S1[e] -= dl; } \
            const float al0 = __shfl(alpha, 4 * g), al1 = __shfl(alpha, 4 * g + 1), al2 = __shfl(alpha, 4 * g + 2), al3 = __shfl(alpha, 4 * g + 3); \
            Ls[0] *= al0; Ls[1] *= al1; Ls[2] *= al2; Ls[3] *= al3; \
            _Pragma("unroll") for (int cc = 0; cc < 8; ++cc) { O[cc][0] *= al0; O[cc][1] *= al1; O[cc][2] *= al2; O[cc][3] *= al3; } } \
        u32x4t pw; \
        pw.x = pg8::cvt_pk_bf16(__builtin_amdgcn_exp2f(S0[0]), __builtin_amdgcn_exp2f(S0[1])); pw.y = pg8::cvt_pk_bf16(__builtin_amdgcn_exp2f(S0[2]), __builtin_amdgcn_exp2f(S0[3])); \
        pw.z = pg8::cvt_pk_bf16(__builtin_amdgcn_exp2f(S1[0]), __builtin_amdgcn_exp2f(S1[1])); pw.w = pg8::cvt_pk_bf16(__builtin_amdgcn_exp2f(S1[2]), __builtin_amdgcn_exp2f(S1[3])); \
        const bf16x8 pa = __builtin_bit_cast(bf16x8, pw); \
        _Pragma("unroll") for (int cc = 0; cc < 8; ++cc) { \
            const bf16x8 vb = {vlo[cc][0], vlo[cc][1], vlo[cc][2], vlo[cc][3], vhi[cc][0], vhi[cc][1], vhi[cc][2], vhi[cc][3]}; \
            O[cc] = __builtin_amdgcn_mfma_f32_16x16x32_bf16(pa, vb, O[cc], 0, 0, 0); } \
        Ls = __builtin_amdgcn_mfma_f32_16x16x32_bf16(pa, ones, Ls, 0, 0, 0);     \
        kw0 = kw1; kw1 = kw2; }
        SP_STEP(0) SP_STEP(1) SP_STEP(2) SP_STEP(3) SP_STEP(4) SP_STEP(5) SP_STEP(6) SP_STEP(7)
#undef SP_STEP
        const float i0 = __builtin_amdgcn_rcpf(Ls[0]), i1 = __builtin_amdgcn_rcpf(Ls[1]), i2 = __builtin_amdgcn_rcpf(Ls[2]), i3 = __builtin_amdgcn_rcpf(Ls[3]);
        if (g < 2) {
            LAS bf16* st = (LAS bf16*)(wl + 8192) + (4 * g) * 128 + n;
#pragma unroll
            for (int cc = 0; cc < 8; ++cc) {
                const unsigned w01 = pg8::cvt_pk_bf16(O[cc][0] * i0, O[cc][1] * i1), w23 = pg8::cvt_pk_bf16(O[cc][2] * i2, O[cc][3] * i3);
                LAS u16* s16 = (LAS u16*)st;
                s16[0 * 128 + 16 * cc] = (u16)(w01 & 0xffffu); s16[1 * 128 + 16 * cc] = (u16)(w01 >> 16);
                s16[2 * 128 + 16 * cc] = (u16)(w23 & 0xffffu); s16[3 * 128 + 16 * cc] = (u16)(w23 >> 16);
            }
        }
        LDS_WAIT(); asm volatile("" ::: "memory");
        if (!dry) {
#pragma unroll
            for (int i = 0; i < 2; ++i) *(GAS u32x4t*)(ATT + (size_t)row * 1536 + 512 + 8 * (lane + 64 * i)) = *(const LAS u32x4t*)(wl + 8192 + 16 * (lane + 64 * i));
        }
        LDS_WAIT(); asm volatile("" ::: "memory");
        row = rown;
    }
    asm volatile("s_waitcnt vmcnt(0)" ::: "memory"); __syncthreads();
    if (nq == 16 && !dry) {
        typedef unsigned u32x2t __attribute__((ext_vector_type(2)));
        bf16x8 wa[4][4];
        const bf16* uvt = Wl + W_UVT + ((size_t)hh * 64 + n) * 128 + 8 * g;
#pragma unroll
        for (int dt = 0; dt < 4; ++dt)
#pragma unroll
            for (int s = 0; s < 4; ++s) wa[dt][s] = *(const bf16x8*)(uvt + (size_t)dt * 16 * 128 + 32 * s);
#pragma unroll
        for (int half = 0; half < 2; ++half) {
            bf16x8 ol[4][4];
#pragma unroll
            for (int t4 = 0; t4 < 4; ++t4) { const bf16* ar = ATT + (size_t)(base0 + 4 * half + t4 + n * qstride) * 1536 + 512 + hh * 128 + 8 * g;
#pragma unroll
                for (int s = 0; s < 4; ++s) ol[t4][s] = *(const bf16x8*)(ar + 32 * s); }
            asm volatile("s_waitcnt vmcnt(0)" ::: "memory"); __syncthreads();
#pragma unroll
            for (int t4 = 0; t4 < 4; ++t4) { bf16* ar = ATT + (size_t)(base0 + 4 * half + t4 + n * qstride) * 1536 + 512 + hh * 64 + 4 * g;
#pragma unroll
                for (int dt = 0; dt < 4; ++dt) { f32x4 d = {0.f, 0.f, 0.f, 0.f};
#pragma unroll
                    for (int s = 0; s < 4; ++s) d = __builtin_amdgcn_mfma_f32_16x16x32_bf16(wa[dt][s], ol[t4][s], d, 0, 0, 0);
                    u32x2t w; w.x = pk2(d[0], d[1]); w.y = pk2(d[2], d[3]);
                    *(GAS u32x2t*)(ar + 16 * dt) = w; } }
        }
    }
#undef SP_ISSUE
#undef SP_KEY
#undef SP_LANDED
#undef SP_LOADQ
}
__device__ __forceinline__ void final_norm_phase(float* out, const bf16* HB, const float* SSQ, const float* g, Frame& F) {
    const bool xb = F.G == 256;
    const int gw = xb ? (F.vcu >> 5) * SEQ + (F.vcu & 31) * NWAVES + F.wave : F.vcu * NWAVES + F.wave, NGW = xb ? 32 * NWAVES : F.G * NWAVES, me = xb ? ((F.vcu >> 5) + 1) * SEQ : M;
    f32x4 gv[4];
#pragma unroll
    for (int j = 0; j < 2; ++j) { gv[2 * j] = *(const f32x4*)(g + 512 * j + 8 * F.lane); gv[2 * j + 1] = *(const f32x4*)(g + 512 * j + 8 * F.lane + 4); }
    for (int m = gw; m < me; m += NGW) {
        const float rs = pg8::row_rstd(SSQ, m);
#pragma unroll
        for (int j = 0; j < 2; ++j) { const v4u b = *(const GAS v4u*)(HB + (size_t)m * D + 512 * j + 8 * F.lane);
            const f32x4 v0 = {__uint_as_float(b.x << 16), __uint_as_float(b.x & 0xffff0000u), __uint_as_float(b.y << 16), __uint_as_float(b.y & 0xffff0000u)};
            const f32x4 v1 = {__uint_as_float(b.z << 16), __uint_as_float(b.z & 0xffff0000u), __uint_as_float(b.w << 16), __uint_as_float(b.w & 0xffff0000u)};
            float* o = out + (size_t)m * D + 512 * j + 8 * F.lane;
            *(GAS f32x4*)o = v0 * rs * gv[2 * j]; *(GAS f32x4*)(o + 4) = v1 * rs * gv[2 * j + 1]; }
    }
}
__global__ void __launch_bounds__(NWAVES * 64, 2) trunk_fwd(Params P) {
    extern __shared__ __attribute__((aligned(16))) unsigned char lds_raw[];
    Frame F;
    F.lds = (LAS unsigned char*)lds_raw;
    F.tid = threadIdx.x; F.lane = F.tid & 63; F.wave = __builtin_amdgcn_readfirstlane(F.tid >> 6);
    F.G = gridDim.x; { const int bx = blockIdx.x; F.vcu = (F.G % 8 == 0) ? (bx % 8) * (F.G / 8) + bx / 8 : bx; }
    volatile LAS unsigned* MISC = (volatile LAS unsigned*)(F.lds + MISC_OFF);
    for (int u = F.tid; u < 64; u += NWAVES * 64) MISC[u] = 0u;
    __syncthreads();
    typedef const __attribute__((address_space(4))) Params* kparams_t;
#define KP() ({ kparams_t kp_ = (kparams_t)__builtin_amdgcn_kernarg_segment_ptr(); asm volatile("" : "+s"(kp_)); kp_; })
    const int lo = P.ph_lo, hi = P.ph_hi;
#if MK_PER_PHASE
#define GRID_BAR() do { } while (0)
#else
    XcdBarrier bar = xcd_barrier_post((unsigned*)((gu32*)(P.ws + WS_CTL) + CW_BAR), MISC + 8);
    if (threadIdx.x == 0 && gridDim.x == 256) (void)__hip_atomic_fetch_or((unsigned*)((gu32*)(P.ws + WS_CTL)) + CW_XL_MASK(blockIdx.x & 7), 1u << xb_xcc_id(), __ATOMIC_RELAXED, __HIP_MEMORY_SCOPE_AGENT);
#define GRID_BAR() xcd_barrier(bar)
#endif
#define IN(k) (lo <= (k) && (k) < hi)
#define MKF() Frame Fp; { int t_ = threadIdx.x, g_ = gridDim.x, b_ = blockIdx.x; asm volatile("" : "+v"(t_), "+s"(g_), "+s"(b_)); Fp.lds = F.lds; Fp.tid = t_; Fp.lane = t_ & 63; Fp.wave = __builtin_amdgcn_readfirstlane(t_ >> 6); \
        Fp.G = g_; Fp.bx = b_; Fp.vcu = (g_ % 8 == 0) ? (b_ % 8) * (g_ / 8) + b_ / 8 : b_; }
#define SEAM(k) do { if (IN(k) && IN((k) + 1)) GRID_BAR(); } while (0)
#define SEAM_G(k) do { if (IN(k) && IN((k) + 1)) { if (MISC[12]) { kparams_t kp_ = KP(); int b_ = blockIdx.x; asm volatile("" : "+s"(b_)); group_barrier((unsigned*)((gu32*)(kp_->ws + WS_CTL)), (unsigned)b_ & 7u, 32u); } else GRID_BAR(); } } while (0)

#if PROBE_MODE == 4
    if (IN(0)) { kparams_t kp = KP(); MKF(); prologue_phase(kp, Fp); VM_WAIT(); __syncthreads(); }
#endif
    if (IN(0)) { kparams_t kp = KP(); MKF(); prologue_phase(kp, Fp); VM_WAIT(); __syncthreads(); }
    SEAM(0);
#if !MK_PER_PHASE
    { if (threadIdx.x == 0) { unsigned ok = (gridDim.x == 256) ? 1u : 0u;
          if (ok) { const unsigned* ctl_ = (const unsigned*)((gu32*)(P.ws + WS_CTL));
#pragma unroll
              for (int g = 0; g < 8; ++g) { const unsigned mk_ = __hip_atomic_load(ctl_ + CW_XL_MASK(g), __ATOMIC_RELAXED, __HIP_MEMORY_SCOPE_AGENT); ok &= (__popc(mk_) == 1) ? 1u : 0u; } }
          MISC[12] = ok; }
      __syncthreads(); }
#endif
    for (int l = 0; l < DEPTH; ++l) {
        const int pb = 1 + 8 * l;
        if (IN(pb + 0)) { kparams_t kp = KP(); MKF(); unsigned char* ws = kp->ws; const bf16* Wl = (const bf16*)(ws + WS_W) + (size_t)l * W_LAYER;
            pg8::Gemm g{(const bf16*)(ws + WS_HB8), Wl + W_GU1, M, NGU, D / 2, D / 2};     pg8::StaticOrder S; S.init(M, NGU, Fp.G, Fp.bx);
            pg8::EpiSwiGLU E{ws + WS_BIG, HID_P, (const float*)(ws + WS_SSQ), Fp.lds + RSTD_OFF, (const float*)(ws + WS_WSC) + (size_t)l * WSC_LAYER + WSC_GU1};
            if (Fp.lane == 0) *(LAS float*)(Fp.lds + RSTD_OFF + Fp.wave * 1024 + 512) = __int_as_float(-1);
            pg8::gemm_phase<pg8::EpiSwiGLU, pg8::StaticOrder, true, true, true>(Fp.lds + RING_OFF, g, S, E);
            }
        SEAM_G(pb + 0);
        if (IN(pb + 1)) { kparams_t kp = KP(); MKF(); unsigned char* ws = kp->ws; const bf16* Wl = (const bf16*)(ws + WS_W) + (size_t)l * W_LAYER;
            pg8::Gemm g{(const bf16*)(ws + WS_BIG), Wl + W_D1, M, D, DFF / 2, HID_P / 2}; pg8::StaticOrder S; S.init(M, D, Fp.G, Fp.bx);
            pg8::EpiRes<(long)WS_HB8 - (long)WS_HB, true> E{(bf16*)(ws + WS_HB), (float*)(ws + WS_SSQ), 0.5f / pg8::F8_HID, (const float*)(ws + WS_WSC) + (size_t)l * WSC_LAYER + WSC_D1};
            pg8::gemm_phase<pg8::EpiRes<(long)WS_HB8 - (long)WS_HB, true>, pg8::StaticOrder, true, true, true>(Fp.lds + RING_OFF, g, S, E); }
        SEAM_G(pb + 1);
        { int nseg_ = 2; asm volatile("" : "+s"(nseg_));
          for (int seg_ = 0; seg_ < nseg_; ++seg_) {
        if (IN(pb + 2)) { kparams_t kp = KP(); MKF(); unsigned char* ws = kp->ws; const bf16* Wl = (const bf16*)(ws + WS_W) + (size_t)l * W_LAYER;
            pg8::Gemm g{(const bf16*)(ws + WS_HB8), Wl + W_IN, M, NIN, D / 2, D / 2}; pg8::WindowOrder S; S.init(M, NIN, Fp.G, Fp.bx);
            { const bool rg = Fp.G == 256; const int big = 1 << 20; S.rot = 2; S.i0 = seg_ ? (rg ? 5 : big) : 0; S.i1 = seg_ ? (rg ? 6 : big) : (rg ? 5 : big); }
            pg8::EpiProj E{(bf16*)(ws + WS_ATT), (bf16*)(ws + WS_QI), (bf16*)(ws + WS_FK), (bf16*)(ws + WS_FV), (bf16*)(ws + WS_KI), (float*)(ws + WS_CR), (float*)(ws + WS_WI), (float*)(ws + WS_FL), (const float*)(ws + WS_SSQ), Fp.lds + RSTD_OFF, (const float*)(ws + WS_WSC) + (size_t)l * WSC_LAYER + WSC_IN, (unsigned*)(ws + WS_CTL) + CW_NRM + l * 128};
            if (Fp.lane == 0) *(LAS float*)(Fp.lds + RSTD_OFF + Fp.wave * 1024 + 512) = __int_as_float(-1);
            pg8::gemm_phase<pg8::EpiProj, pg8::WindowOrder, true, true, true>(Fp.lds + RING_OFF, g, S, E);
            }
        if (seg_ == 0) SEAM_G(pb + 2);
          } }
        if (IN(pb + 3)) {
            { kparams_t kp = KP(); MKF(); unsigned char* ws = kp->ws;
              for (int v = Fp.vcu; v < 256; v += Fp.G) scan_unit((const float*)(ws + WS_FL), kp->in[7] + l * 8, (float*)(ws + WS_CUM), v >> 2, Fp);
              ckv_rows((const float*)(ws + WS_CR), kp->in[8] + l * 128, (bf16*)(ws + WS_CKV), Fp); }
            VM_WAIT(); __syncthreads();
            if (threadIdx.x == 0) { __builtin_amdgcn_fence(__ATOMIC_ACQUIRE, "agent"); VM_WAIT(); }
            __syncthreads();
            { kparams_t kp = KP(); MKF(); unsigned char* ws = kp->ws; bf16* ATT = (bf16*)(ws + WS_ATT);
              const attn_body::AttnTensors AT{(const attn_body::bf16*)ATT, (const attn_body::bf16*)(ws + WS_FK), (const attn_body::bf16*)(ws + WS_FV), (attn_body::bf16*)ATT, (const float*)(ws + WS_CUM), (const unsigned*)(ws + WS_CTL) + CW_NRM + l * 128};
              attn_body::attn_phase<64>((char*)lds_raw + RING_OFF, AT, Fp.vcu, Fp.G); }
            VM_WAIT(); __syncthreads();
            { kparams_t kp = KP(); MKF(); unsigned char* ws = kp->ws;
              const bool xq = Fp.G == 256;
              gu32* qctr = (gu32*)(ws + WS_CTL) + CW_TOPKQ + 64 * (xq ? 8 * l + (Fp.vcu >> 5) : l);
              bool pre = false; int cur = xq ? (((Fp.vcu & 31) << 3) | (Fp.vcu >> 5)) : Fp.vcu, par = 0;
              while (cur < 2048) { int nxt = 2048;
                  pre = topk_unit((const bf16*)(ws + WS_QI), (const bf16*)(ws + WS_KI), (const float*)(ws + WS_WI), (u16*)(ws + WS_IDX), cur & 7, 255 - (cur >> 3), qctr, Fp.G,
                                  (LAS unsigned*)(Fp.lds + MISC_OFF + 96) + par, pre, nxt, Fp);
                  cur = nxt; par ^= 1; } }
            VM_WAIT(); __syncthreads();
        }
        SEAM_G(pb + 3);
        if (IN(pb + 4)) {
            { kparams_t kp = KP(); MKF(); build_lut(kp->in[16], Fp); }
            __syncthreads();
            { kparams_t kp = KP(); MKF(); unsigned char* ws = kp->ws;
#if PROBE_MODE == 2
              { const int dry_ = (int)(kp->ph_hi > 0); sparse_phase((bf16*)(ws + WS_ATT), (const bf16*)(ws + WS_CKV), (const u16*)(ws + WS_IDX), (const bf16*)(ws + WS_W) + (size_t)l * W_LAYER, Fp.vcu * NWAVES + Fp.wave, Fp.G * NWAVES, M / (Fp.G * NWAVES), Fp, dry_); }
#endif
              const bool xb = Fp.G == 256;
              sparse_phase((bf16*)(ws + WS_ATT), (const bf16*)(ws + WS_CKV), (const u16*)(ws + WS_IDX), (const bf16*)(ws + WS_W) + (size_t)l * W_LAYER,
                           xb ? (Fp.vcu >> 5) * SEQ + (Fp.vcu & 31) * NWAVES + Fp.wave : Fp.vcu * NWAVES + Fp.wave, xb ? 256 : Fp.G * NWAVES, xb ? 16 : M / (Fp.G * NWAVES), Fp); }
            VM_WAIT(); __syncthreads();
        }
        SEAM_G(pb + 4);
        if (IN(pb + 5)) { kparams_t kp = KP(); MKF(); unsigned char* ws = kp->ws; const bf16* Wl = (const bf16*)(ws + WS_W) + (size_t)l * W_LAYER;
            pg8::Gemm g{(const bf16*)(ws + WS_ATT), Wl + W_OUT, M, D, KOUT, ATT_P}; pg8::StaticOrder S; S.init(M, D, Fp.G, Fp.bx);
            pg8::EpiRes<(long)WS_HB8 - (long)WS_HB> E{(bf16*)(ws + WS_HB), (float*)(ws + WS_SSQ), 1.0f, nullptr};
            pg8::gemm_phase<pg8::EpiRes<(long)WS_HB8 - (long)WS_HB>, pg8::StaticOrder, true, true>(Fp.lds + RING_OFF, g, S, E); }
        SEAM_G(pb + 5);
        if (IN(pb + 6)) { kparams_t kp = KP(); MKF(); unsigned char* ws = kp->ws; const bf16* Wl = (const bf16*)(ws + WS_W) + (size_t)l * W_LAYER;
            pg8::Gemm g{(const bf16*)(ws + WS_HB8), Wl + W_GU2, M, NGU, D / 2, D / 2}; pg8::StaticOrder S; S.init(M, NGU, Fp.G, Fp.bx);
            pg8::EpiSwiGLU E{ws + WS_BIG, HID_P, (const float*)(ws + WS_SSQ), Fp.lds + RSTD_OFF, (const float*)(ws + WS_WSC) + (size_t)l * WSC_LAYER + WSC_GU2};
            if (Fp.lane == 0) *(LAS float*)(Fp.lds + RSTD_OFF + Fp.wave * 1024 + 512) = __int_as_float(-1);
            pg8::gemm_phase<pg8::EpiSwiGLU, pg8::StaticOrder, true, true, true>(Fp.lds + RING_OFF, g, S, E); }
        SEAM_G(pb + 6);
        if (IN(pb + 7)) { kparams_t kp = KP(); MKF(); unsigned char* ws = kp->ws; const bf16* Wl = (const bf16*)(ws + WS_W) + (size_t)l * W_LAYER;
            pg8::Gemm g{(const bf16*)(ws + WS_BIG), Wl + W_D2, M, D, DFF / 2, HID_P / 2}; pg8::StaticOrder S; S.init(M, D, Fp.G, Fp.bx);
            pg8::EpiRes<(long)WS_HB8 - (long)WS_HB, true> E{(bf16*)(ws + WS_HB), (float*)(ws + WS_SSQ), 0.5f / pg8::F8_HID, (const float*)(ws + WS_WSC) + (size_t)l * WSC_LAYER + WSC_D2};
            pg8::gemm_phase<pg8::EpiRes<(long)WS_HB8 - (long)WS_HB, true>, pg8::StaticOrder, true, true, true>(Fp.lds + RING_OFF, g, S, E); }
        SEAM_G(pb + 7);
    }
    if (IN(NPHASE - 1)) { kparams_t kp = KP(); MKF(); final_norm_phase(kp->out, (const bf16*)(kp->ws + WS_HB), (const float*)(kp->ws + WS_SSQ), kp->in[17], Fp); }
#undef IN
#undef MKF
#undef SEAM
#undef GRID_BAR
}

extern "C" void kernel_launch(void* const* d_in, const int* in_sizes, int n_in, void* d_out, int out_size, void* d_ws, size_t ws_size, hipStream_t stream) {
    static int grid = 0;
    if (grid == 0) {
        if (n_in != 18 || in_sizes[0] != M * D || out_size != M * D || ws_size < WS_END) { fprintf(stderr, "kernel_launch: unexpected shapes (n_in %d, in0 %d, out %d, ws %zu < %zu); nothing launched\n", n_in, n_in > 0 ? in_sizes[0] : -1, out_size, ws_size, (size_t)WS_END); grid = -1; return; }
        int dev = 0, cus = 0, per_cu = 0;
        if (hipGetDevice(&dev) != hipSuccess || hipDeviceGetAttribute(&cus, hipDeviceAttributeMultiprocessorCount, dev) != hipSuccess) { grid = -1; return; }
        if (hipFuncSetAttribute((const void*)trunk_fwd, hipFuncAttributeMaxDynamicSharedMemorySize, LDS_BYTES) != hipSuccess) { fprintf(stderr, "kernel_launch: hipFuncSetAttribute failed\n"); grid = -1; return; }
        if (hipOccupancyMaxActiveBlocksPerMultiprocessor(&per_cu, (const void*)trunk_fwd, NWAVES * 64, LDS_BYTES) != hipSuccess || per_cu < 1) { fprintf(stderr, "kernel_launch: occupancy query says %d\n", per_cu); }
        (void)hipGetLastError();
        grid = cus;
    }
    if (grid < 0) return;
    if (hipMemsetAsync((char*)d_ws + WS_CTL, 0, CTL_ZERO_BYTES, stream) != hipSuccess) return;
    Params p{};
    for (int i = 0; i < 18; ++i) p.in[i] = (const float*)d_in[i];
    p.out = (float*)d_out; p.ws = (unsigned char*)d_ws;
#if MK_PER_PHASE
    for (int ph = 0; ph < NPHASE; ++ph) { p.ph_lo = ph; p.ph_hi = ph + 1; hipLaunchKernelGGL(trunk_fwd, dim3(grid), dim3(NWAVES * 64), LDS_BYTES, stream, p); }
#else
    p.ph_lo = 0; p.ph_hi = NPHASE;
    hipLaunchKernelGGL(trunk_fwd, dim3(grid), dim3(NWAVES * 64), LDS_BYTES, stream, p);
#endif
}
```
